# Optimizing an MI355X kernel written in HIP

```python
import jax, jax.numpy as jnp
from jax import lax
import numpy as np

D_MODEL = 1024
BATCH = 8
SEQ = 4096
DEPTH = 2

N_MIXERS = 2
N_A_LAYERS = (DEPTH + 1) // 2
N_B_LAYERS = DEPTH // 2

N_HEADS = 16
HEAD_DIM = 64
N_KV_HEADS = 4
GROUP = N_HEADS // N_KV_HEADS
IDX_HEADS = 8
IDX_DIM = 64
TOPK_MAX = 256
Q_BLOCK = 128
Q_W = N_HEADS * HEAD_DIM
KV_W = N_KV_HEADS * HEAD_DIM
IQ_W = IDX_HEADS * IDX_DIM
DSA_WIDTHS = (Q_W, KV_W, KV_W, IQ_W, IDX_DIM, IDX_HEADS)
DSA_IN = sum(DSA_WIDTHS)
DSA_SPLITS = tuple(int(s) for s in np.cumsum(DSA_WIDTHS)[:-1])

RWKV_HEAD = 64
RWKV_HEADS = D_MODEL // RWKV_HEAD
DECAY_LORA = 64
AAA_LORA = 64
GATE_LORA = 160
GN_EPS = 64e-5

D_FF = 2816
N_MOD = 9
RMS_EPS = 1e-6

kernel_name = "hybrid_dsa_rwkv7_macaron_adaln"


def rms(x):
    xf = x.astype(jnp.float32)
    return (xf * lax.rsqrt(jnp.mean(xf * xf, axis=-1, keepdims=True) + RMS_EPS)).astype(x.dtype)


def modulate(h, shift, scale):
    return rms(h) * (1 + scale[:, None, :]) + shift[:, None, :]


def swiglu(x, w_gu, w_down):
    gate, up = jnp.split(x @ w_gu, 2, axis=-1)
    return (jax.nn.silu(gate) * up) @ w_down


def dsa_mixer(x, w_in, q_norm, k_norm, ik_norm, w_out):
    B, S, _ = x.shape
    k_top = min(TOPK_MAX, S // 4)
    q, k, v, iq, ik, iw = jnp.split(x @ w_in, DSA_SPLITS, axis=-1)
    q = rms(q.reshape(B, S, N_KV_HEADS, GROUP, HEAD_DIM)) * q_norm
    k = rms(k.reshape(B, S, N_KV_HEADS, HEAD_DIM)) * k_norm
    v = v.reshape(B, S, N_KV_HEADS, HEAD_DIM)
    iq = iq.reshape(B, S, IDX_HEADS, IDX_DIM)
    ik = rms(ik) * ik_norm
    iw = iw * (IDX_HEADS ** -0.5 * IDX_DIM ** -0.5)
    nb = S // Q_BLOCK
    key_pos = jnp.arange(S)

    def to_blocks(a):
        return jnp.moveaxis(a.reshape(B, nb, Q_BLOCK, *a.shape[2:]), 1, 0)

    def block(args):
        qb, iqb, iwb, start = args
        qpos = start + jnp.arange(Q_BLOCK)
        rel = jax.nn.relu(jnp.einsum('bqhd,bsd->bqhs', iqb, ik))
        score = jnp.einsum('bqhs,bqh->bqs', rel, iwb).astype(jnp.float32)
        causal = key_pos[None, :] <= qpos[:, None]
        score = jnp.where(causal[None], score, -jnp.inf)
        _, sel = lax.top_k(score, k_top)
        valid = sel <= qpos[None, :, None]
        k_sel = jax.vmap(lambda kk, ii: kk[ii])(k, sel)
        v_sel = jax.vmap(lambda vv, ii: vv[ii])(v, sel)
        logits = jnp.einsum('bqhgd,bqkhd->bqhgk', qb, k_sel).astype(jnp.float32) * (HEAD_DIM ** -0.5)
        logits = jnp.where(valid[:, :, None, None, :], logits, -jnp.inf)
        p = jax.nn.softmax(logits, axis=-1).astype(v.dtype)
        return jnp.einsum('bqhgk,bqkhd->bqhgd', p, v_sel)

    starts = jnp.arange(nb, dtype=jnp.int32) * Q_BLOCK
    o = lax.map(block, (to_blocks(q), to_blocks(iq), to_blocks(iw), starts))
    o = jnp.moveaxis(o, 0, 1).reshape(B, S, Q_W)
    return o @ w_out


def rwkv7_mixer(x, mu, w_rkv, w0, w1, w2, a0, a1, a2, g1, g2, k_k, k_a, r_k, ln_w, ln_b, w_out):
    B, S, D = x.shape
    H, N = RWKV_HEADS, RWKV_HEAD
    f32 = jnp.float32
    xx = jnp.pad(x, ((0, 0), (1, 0), (0, 0)))[:, :-1] - x
    xrkv = x[None] + xx[None] * mu[:3, None, None, :]
    r, k, v = jnp.einsum('nbsd,nde->nbse', xrkv, w_rkv)
    xw = x + xx * mu[3]
    xa = x + xx * mu[4]
    xg = x + xx * mu[5]
    w_log = -jax.nn.softplus(-(w0 + jnp.tanh(xw @ w1) @ w2)) - 0.5
    decay = jnp.exp(-jnp.exp(w_log.astype(f32)))
    a = jax.nn.sigmoid(a0 + (xa @ a1) @ a2)
    g = jax.nn.sigmoid(xg @ g1) @ g2
    kk = (k * k_k).astype(f32).reshape(B, S, H, N)
    kk = kk / jnp.maximum(jnp.sqrt(jnp.sum(kk * kk, axis=-1, keepdims=True)), 1e-12)
    k = k * (1 + (a - 1) * k_a)
    rh = r.astype(f32).reshape(B, S, H, N)
    kh = k.astype(f32).reshape(B, S, H, N)
    vh = v.astype(f32).reshape(B, S, H, N)
    ah = a.astype(f32).reshape(B, S, H, N)
    wh = decay.reshape(B, S, H, N)
    bh = kk * ah

    def step(state, inp):
        r_t, w_t, k_t, v_t, kk_t, b_t = inp
        sa = jnp.einsum('bhvk,bhk->bhv', state, -kk_t)
        state = (state * w_t[:, :, None, :] + sa[..., None] * b_t[:, :, None, :]
                 + v_t[..., None] * k_t[:, :, None, :])
        return state, jnp.einsum('bhvk,bhk->bhv', state, r_t)

    tf = lambda t: jnp.moveaxis(t, 1, 0)
    state0 = jnp.zeros((B, H, N, N), f32)
    _, y = lax.scan(step, state0, (tf(rh), tf(wh), tf(kh), tf(vh), tf(kk), tf(bh)))
    y = jnp.moveaxis(y, 0, 1)
    mean = jnp.mean(y, axis=-1, keepdims=True)
    var = jnp.mean(jnp.square(y - mean), axis=-1, keepdims=True)
    yn = ((y - mean) * lax.rsqrt(var + GN_EPS)).reshape(B, S, D) * ln_w.astype(f32) + ln_b.astype(f32)
    bonus = (jnp.sum(rh * kh * r_k.astype(f32), axis=-1, keepdims=True) * vh).reshape(B, S, D)
    out = ((yn + bonus).astype(x.dtype)) * g
    return out @ w_out


def setup_inputs(seed: int = 0) -> dict:
    key = jax.random.key(seed)
    ks = jax.random.split(key, 32)
    f32 = jnp.float32
    D = D_MODEL

    def nrm(k, shape, fan_in, scale=1.0):
        return jax.random.normal(k, shape, f32) * (scale * fan_in ** -0.5)

    def near_one(k, shape):
        return 1.0 + 0.02 * jax.random.normal(k, shape, f32)

    return {
        "x": jax.random.normal(ks[0], (BATCH, SEQ, D), f32),
        "c": jax.random.normal(ks[1], (BATCH, D), f32),
        "ada_w": nrm(ks[2], (DEPTH, D, N_MOD * D), D, 0.5),
        "ada_b": 0.02 * jax.random.normal(ks[3], (DEPTH, N_MOD * D), f32),
        "ffn_w_gu": nrm(ks[4], (DEPTH, 2, D, 2 * D_FF), D),
        "ffn_w_down": nrm(ks[5], (DEPTH, 2, D_FF, D), D_FF),
        "dsa_w_in": nrm(ks[6], (N_A_LAYERS, D, DSA_IN), D),
        "dsa_q_norm": near_one(ks[7], (N_A_LAYERS, HEAD_DIM)),
        "dsa_k_norm": near_one(ks[8], (N_A_LAYERS, HEAD_DIM)),
        "dsa_ik_norm": near_one(ks[9], (N_A_LAYERS, IDX_DIM)),
        "dsa_w_out": nrm(ks[10], (N_A_LAYERS, Q_W, D), Q_W),
        "rwkv_mu": jax.random.uniform(ks[11], (N_B_LAYERS, 6, D), f32),
        "rwkv_w_rkv": nrm(ks[12], (N_B_LAYERS, 3, D, D), D),
        "rwkv_w0": jax.random.uniform(ks[13], (N_B_LAYERS, D), f32, -6.0, -1.0),
        "rwkv_w1": nrm(ks[14], (N_B_LAYERS, D, DECAY_LORA), D),
        "rwkv_w2": nrm(ks[15], (N_B_LAYERS, DECAY_LORA, D), DECAY_LORA, 0.1),
        "rwkv_a0": 0.1 * jax.random.normal(ks[16], (N_B_LAYERS, D), f32),
        "rwkv_a1": nrm(ks[17], (N_B_LAYERS, D, AAA_LORA), D),
        "rwkv_a2": nrm(ks[18], (N_B_LAYERS, AAA_LORA, D), AAA_LORA, 0.5),
        "rwkv_g1": nrm(ks[19], (N_B_LAYERS, D, GATE_LORA), D),
        "rwkv_g2": nrm(ks[20], (N_B_LAYERS, GATE_LORA, D), GATE_LORA),
        "rwkv_k_k": 0.85 + 0.02 * jax.random.normal(ks[21], (N_B_LAYERS, D), f32),
        "rwkv_k_a": near_one(ks[22], (N_B_LAYERS, D)),
        "rwkv_r_k": 0.1 * jax.random.normal(ks[23], (N_B_LAYERS, RWKV_HEADS, RWKV_HEAD), f32),
        "rwkv_ln_w": near_one(ks[24], (N_B_LAYERS, D)),
        "rwkv_ln_b": 0.02 * jax.random.normal(ks[25], (N_B_LAYERS, D), f32),
        "rwkv_w_out": nrm(ks[26], (N_B_LAYERS, D, D), D),
    }


def reference(x, c, ada_w, ada_b, ffn_w_gu, ffn_w_down, dsa_w_in, dsa_q_norm, dsa_k_norm,
              dsa_ik_norm, dsa_w_out, rwkv_mu, rwkv_w_rkv, rwkv_w0, rwkv_w1, rwkv_w2, rwkv_a0,
              rwkv_a1, rwkv_a2, rwkv_g1, rwkv_g2, rwkv_k_k, rwkv_k_a, rwkv_r_k, rwkv_ln_w,
              rwkv_ln_b, rwkv_w_out):
    h = x
    c_act = jax.nn.silu(c)
    for i in range(DEPTH):
        mod = c_act @ ada_w[i] + ada_b[i]
        sh1, sc1, gt1, sh2, sc2, gt2, sh3, sc3, gt3 = jnp.split(mod, N_MOD, axis=-1)
        h = h + 0.5 * gt1[:, None, :] * swiglu(modulate(h, sh1, sc1), ffn_w_gu[i, 0], ffn_w_down[i, 0])
        u = modulate(h, sh2, sc2)
        j = i // N_MIXERS
        if i % N_MIXERS == 0:
            m = dsa_mixer(u, dsa_w_in[j], dsa_q_norm[j], dsa_k_norm[j], dsa_ik_norm[j], dsa_w_out[j])
        else:
            m = rwkv7_mixer(u, rwkv_mu[j], rwkv_w_rkv[j], rwkv_w0[j], rwkv_w1[j], rwkv_w2[j],
                            rwkv_a0[j], rwkv_a1[j], rwkv_a2[j], rwkv_g1[j], rwkv_g2[j],
                            rwkv_k_k[j], rwkv_k_a[j], rwkv_r_k[j], rwkv_ln_w[j], rwkv_ln_b[j],
                            rwkv_w_out[j])
        h = h + gt2[:, None, :] * m
        h = h + 0.5 * gt3[:, None, :] * swiglu(modulate(h, sh3, sc3), ffn_w_gu[i, 1], ffn_w_down[i, 1])
    return h
```

```cpp
#include <hip/hip_runtime.h>
#include <hip/hip_cooperative_groups.h>
#include <cstdio>
#include <cstdint>
namespace cg = cooperative_groups;
namespace pg8 {
#define PG8_LAS __attribute__((address_space(3)))
typedef unsigned short bf16_t;
typedef short bf16x8 __attribute__((ext_vector_type(8)));
typedef float f32x4 __attribute__((ext_vector_type(4)));
typedef unsigned u32x4 __attribute__((ext_vector_type(4)));
constexpr int BM = 256, BK = 64, HALF = 128, HTB = HALF * BK * 2  , STAGE_BYTES = 8 * HTB, NXCD = 8, WGM = 8;

__host__ __device__ __forceinline__ int lds_byte(int r, int c) { const int st = (r >> 4) * 2 + (c >> 5), rr = r & 15, cc = c & 31, ob = rr * 64 + cc * 2; return st * 1024 + (ob ^ (((ob >> 9) & 1) << 5)); }
__host__ __device__ __forceinline__ void stage_rc(int b, int& R, int& C) { const int st = b / 1024, sb = b % 1024, swz = sb ^ (((sb >> 9) & 1) << 5); R = (st >> 1) * 16 + swz / 64; C = (st & 1) * 32 + (swz % 64) / 2; }
__host__ __device__ __forceinline__ int perm32(int rho) { const int n = rho >> 4, i = rho & 15; return 8 * (i >> 2) + 4 * n + (i & 3); }

struct Unit { int pm, pn; };
struct Gemm { const bf16_t* A; const bf16_t* Bt; int M, N, K, lda; };

struct StaticOrder {
    int nM, nN, nwg, G, c;
    __host__ __device__ void init(int M, int N, int G_, int c_) { nM = M / BM; nN = N / BM; nwg = nM * nN; G = G_; c = c_; }
    __host__ __device__ bool next(int i, Unit& u) const {
        const long L = (long)i * G + c; if (L >= nwg) return false;
        int wgid = (int)L; { const int q = nwg / NXCD, r = nwg % NXCD, xcd = wgid % NXCD, off = wgid / NXCD; wgid = (xcd < r ? xcd * (q + 1) : r * (q + 1) + (xcd - r) * q) + off; }
        const int nig = WGM * nN, gid = wgid / nig, fm = gid * WGM, gsz = (nM - fm) < WGM ? (nM - fm) : WGM;
        u.pm = fm + ((wgid % nig) % gsz); u.pn = (wgid % nig) / gsz; return true;
    }
    __device__ __forceinline__ void a_ready(const Unit&) const {}
    __device__ __forceinline__ void done(const Unit&) const {}
};

__device__ __forceinline__ unsigned cvt_pk_bf16(float lo, float hi) { unsigned r; asm volatile("v_cvt_pk_bf16_f32 %0, %1, %2" : "=v"(r) : "v"(lo), "v"(hi)); return r; }
template <class Epi, class Sched, bool ALIGN_EPI = false, bool SP2 = false>
__device__ __forceinline__ void gemm_phase(PG8_LAS unsigned char* lds, const Gemm g, const Sched& S, const Epi& E) {
    int tid_ = threadIdx.x; asm volatile("" : "+v"(tid_));
    const int tid = tid_, wid = __builtin_amdgcn_readfirstlane(tid >> 6), lane = tid & 63, wr = wid >> 2, wc = wid & 3, fr = lane & 15, fq = lane >> 4;
    const int K = g.K, nt = K / BK;
    unsigned voffA[2], voffB[2];
#pragma unroll
    for (int i = 0; i < 2; ++i) { int R, C; stage_rc(tid * 16 + i * 8192, R, C); const int Rb = Epi::PERM ? ((R & ~31) + perm32(R & 31)) : R;
        voffA[i] = (unsigned)(R * g.lda + C) * 2u; voffB[i] = (unsigned)(Rb * K + C) * 2u; }
    const size_t kstep = (size_t)(BK * 2);
    const size_t hstepA = (size_t)HALF * g.lda * 2, hstepB = (size_t)HALF * K * 2;
    const size_t tstepA = 2 * hstepA, tstepB = 2 * hstepB;
    const unsigned ldsw = (unsigned)wid * 1024u;
    const int aoff = lds_byte(wr * 64 + fr, fq * 8), boff = lds_byte(wc * 32 + fr, fq * 8);
#define PG8_SA(b, h) (((b) * 2 + (h)) * HTB)
#define PG8_SB(b, h) ((4 + (b) * 2 + (h)) * HTB)
#define PG8_STAGE(bufoff, gbase, voff) do { _Pragma("unroll") for (int _i = 0; _i < 2; ++_i) \
        __builtin_amdgcn_global_load_lds((const unsigned*)((const char*)(gbase) + (voff)[_i]), (PG8_LAS unsigned*)(lds + (bufoff) + ldsw + _i * 8192), 16, 0, 0); } while (0)
#define PG8_LDA(dst, b, h) do { _Pragma("unroll") for (int m = 0; m < 4; ++m) _Pragma("unroll") for (int k = 0; k < 2; ++k) dst[m][k] = *(const PG8_LAS bf16x8*)(lds + PG8_SA(b, h) + aoff + m * 2048 + k * 1024); } while (0)
#define PG8_LDB(dst, b, h) do { _Pragma("unroll") for (int n = 0; n < 2; ++n) _Pragma("unroll") for (int k = 0; k < 2; ++k) dst[n][k] = *(const PG8_LAS bf16x8*)(lds + PG8_SB(b, h) + boff + n * 2048 + k * 1024); } while (0)
#define PG8_MMA(ai, bj, At, Bt) do { __builtin_amdgcn_s_setprio(1); _Pragma("unroll") for (int m = 0; m < 4; ++m) _Pragma("unroll") for (int n = 0; n < 2; ++n) _Pragma("unroll") for (int k = 0; k < 2; ++k) \
        acc[ai][bj][m][n] = __builtin_amdgcn_mfma_f32_16x16x32_bf16(Bt[n][k], At[m][k], acc[ai][bj][m][n], 0, 0, 0); __builtin_amdgcn_s_setprio(0); } while (0)
#define PG8_WAIT_V(n) asm volatile("s_waitcnt vmcnt(" #n ")" ::: "memory")
#define PG8_WAIT_L(n) asm volatile("s_waitcnt lgkmcnt(" #n ")" ::: "memory")
#define PG8_BAR __builtin_amdgcn_s_barrier()
#define PG8_SCHED __builtin_amdgcn_sched_barrier(0)
    Unit cur, nxt; int ui = 0;
    if (!S.next(0, cur)) return;
    f32x4 acc[2][2][4][2];
#pragma unroll
    for (int a = 0; a < 2; ++a)
#pragma unroll
        for (int b = 0; b < 2; ++b)
#pragma unroll
            for (int m = 0; m < 4; ++m)
#pragma unroll
                for (int n = 0; n < 2; ++n) acc[a][b][m][n] = (f32x4){0.f, 0.f, 0.f, 0.f};
    bf16x8 At[4][2], B0[2][2], B1[2][2];
    const char* cA = (const char*)g.A + (size_t)cur.pm * tstepA; const char* cB = (const char*)g.Bt + (size_t)cur.pn * tstepB;
    S.a_ready(cur);
    if constexpr (SP2) {
        PG8_STAGE(PG8_SB(0, 0), cB, voffB); PG8_STAGE(PG8_SB(0, 1), cB + hstepB, voffB); PG8_STAGE(PG8_SA(0, 0), cA, voffA); PG8_STAGE(PG8_SA(0, 1), cA + hstepA, voffA);
        if (wr == 1) PG8_BAR;
        PG8_WAIT_V(2); PG8_BAR;
        PG8_STAGE(PG8_SB(1, 0), cB + kstep, voffB); PG8_STAGE(PG8_SA(1, 0), cA + kstep, voffA); PG8_STAGE(PG8_SB(1, 1), cB + hstepB + kstep, voffB);
        PG8_WAIT_V(6); PG8_BAR;
    } else {
        PG8_STAGE(PG8_SB(0, 0), cB, voffB); PG8_STAGE(PG8_SA(0, 0), cA, voffA); PG8_STAGE(PG8_SB(0, 1), cB + hstepB, voffB); PG8_STAGE(PG8_SA(0, 1), cA + hstepA, voffA);
        if (wr == 1) PG8_BAR;
        PG8_WAIT_V(4); PG8_BAR;
        PG8_STAGE(PG8_SB(1, 0), cB + kstep, voffB); PG8_STAGE(PG8_SA(1, 0), cA + kstep, voffA); PG8_STAGE(PG8_SB(1, 1), cB + hstepB + kstep, voffB);
        PG8_WAIT_V(6); PG8_BAR;
    }
    for (;;) {
        const bool has_next = S.next(ui + 1, nxt);
        const char* nA = has_next ? (const char*)g.A + (size_t)nxt.pm * tstepA : cA; const char* nB = has_next ? (const char*)g.Bt + (size_t)nxt.pn * tstepB : cB;
        for (int t = 0; t < nt; t += 2) {
            const bool last = (t == nt - 2);
            const char* a1 = cA + (size_t)(t + 1) * kstep;
            const char* a2 = last ? nA : cA + (size_t)(t + 2) * kstep; const char* b2 = last ? nB : cB + (size_t)(t + 2) * kstep;
            const char* a3 = a2 + kstep; const char* b3 = b2 + kstep;
            if (last && has_next) S.a_ready(nxt);
            if constexpr (SP2) {
            PG8_LDB(B0, 0, 0); PG8_LDB(B1, 0, 1); PG8_SCHED; PG8_LDA(At, 0, 0); PG8_STAGE(PG8_SA(1, 1), a1 + hstepA, voffA);
            PG8_WAIT_V(8); PG8_WAIT_L(0); PG8_BAR; PG8_MMA(0, 0, At, B0); PG8_MMA(0, 1, At, B1); PG8_BAR; PG8_SCHED;
            PG8_LDA(At, 0, 1); PG8_STAGE(PG8_SB(0, 0), b2, voffB); PG8_STAGE(PG8_SB(0, 1), b2 + hstepB, voffB); PG8_STAGE(PG8_SA(0, 0), a2, voffA);
            PG8_WAIT_V(8); PG8_WAIT_L(0); PG8_BAR; PG8_MMA(1, 0, At, B0); PG8_MMA(1, 1, At, B1); PG8_BAR; PG8_SCHED;
            PG8_LDB(B0, 1, 0); PG8_LDB(B1, 1, 1); PG8_SCHED; PG8_LDA(At, 1, 0); PG8_STAGE(PG8_SA(0, 1), a2 + hstepA, voffA);
            PG8_WAIT_V(8); PG8_WAIT_L(0); PG8_BAR; PG8_MMA(0, 0, At, B0); PG8_MMA(0, 1, At, B1); PG8_BAR; PG8_SCHED;
            PG8_LDA(At, 1, 1); PG8_STAGE(PG8_SB(1, 0), b3, voffB); PG8_STAGE(PG8_SB(1, 1), b3 + hstepB, voffB); PG8_STAGE(PG8_SA(1, 0), a3, voffA);
            PG8_WAIT_V(8); PG8_WAIT_L(0); PG8_BAR; PG8_MMA(1, 0, At, B0); PG8_MMA(1, 1, At, B1); PG8_BAR; PG8_SCHED;
            } else {
            PG8_LDB(B0, 0, 0); PG8_SCHED; PG8_LDA(At, 0, 0); PG8_STAGE(PG8_SA(1, 1), a1 + hstepA, voffA);
            PG8_WAIT_L(8); PG8_BAR; PG8_WAIT_L(0); PG8_MMA(0, 0, At, B0); PG8_BAR; PG8_SCHED;
            PG8_LDB(B1, 0, 1); PG8_STAGE(PG8_SB(0, 0), b2, voffB);
            PG8_BAR; PG8_WAIT_L(0); PG8_MMA(0, 1, At, B1); PG8_BAR;
            PG8_LDA(At, 0, 1); PG8_STAGE(PG8_SA(0, 0), a2, voffA);
            PG8_BAR; PG8_WAIT_L(0); PG8_MMA(1, 0, At, B0); PG8_BAR; PG8_SCHED;
            PG8_STAGE(PG8_SB(0, 1), b2 + hstepB, voffB);
            PG8_WAIT_V(6); PG8_BAR; PG8_MMA(1, 1, At, B1); PG8_BAR;
            PG8_LDB(B0, 1, 0); PG8_SCHED; PG8_LDA(At, 1, 0); PG8_STAGE(PG8_SA(0, 1), a2 + hstepA, voffA);
            PG8_WAIT_L(8); PG8_BAR; PG8_WAIT_L(0); PG8_MMA(0, 0, At, B0); PG8_BAR; PG8_SCHED;
            PG8_LDB(B1, 1, 1); PG8_STAGE(PG8_SB(1, 0), b3, voffB);
            PG8_BAR; PG8_WAIT_L(0); PG8_MMA(0, 1, At, B1); PG8_BAR;
            PG8_LDA(At, 1, 1); PG8_STAGE(PG8_SA(1, 0), a3, voffA);
            PG8_BAR; PG8_WAIT_L(0); PG8_MMA(1, 0, At, B0); PG8_BAR; PG8_SCHED;
            PG8_STAGE(PG8_SB(1, 1), b3 + hstepB, voffB);
            PG8_WAIT_V(6); PG8_BAR; PG8_MMA(1, 1, At, B1); PG8_BAR;
            }
        }
        if constexpr (ALIGN_EPI) { if (wr == 0) PG8_BAR; }
        if constexpr (!Epi::AFTER_DRAIN) { E(acc, cur, wr, wc, fr, fq); S.done(cur); }
        if (!has_next) break;
#pragma unroll
        for (int a = 0; a < 2; ++a)
#pragma unroll
            for (int b = 0; b < 2; ++b)
#pragma unroll
                for (int m = 0; m < 4; ++m)
#pragma unroll
                    for (int n = 0; n < 2; ++n) acc[a][b][m][n] = (f32x4){0.f, 0.f, 0.f, 0.f};
        cur = nxt; cA = nA; cB = nB; ++ui;
        if constexpr (ALIGN_EPI) { if (wr == 1) PG8_BAR; }
    }
    PG8_WAIT_V(0);
    if constexpr (!ALIGN_EPI) { if (wr == 0) PG8_BAR; }
    PG8_BAR;
    if constexpr (Epi::AFTER_DRAIN) { E.fused(acc, cur, wr, wc, fr, fq, lds, wid, lane); S.done(cur); }
#undef PG8_SA
#undef PG8_SB
#undef PG8_STAGE
#undef PG8_LDA
#undef PG8_LDB
#undef PG8_MMA
#undef PG8_WAIT_V
#undef PG8_WAIT_L
#undef PG8_BAR
#undef PG8_SCHED
}
}
#ifndef REP_INDEX
#define REP_INDEX 1
#endif
#ifndef REP_ATTN
#define REP_ATTN 1
#endif
#ifndef REP_DPREP
#define REP_DPREP 1
#endif
#ifndef REP_SCAN
#define REP_SCAN 1
#endif
#ifndef REP_RWIN
#define REP_RWIN 1
#endif
#define LAS __attribute__((address_space(3)))
typedef unsigned short bf16;
typedef float f32x4 __attribute__((ext_vector_type(4)));
typedef float f32x2 __attribute__((ext_vector_type(2)));
typedef float f32x16 __attribute__((ext_vector_type(16)));
typedef short bf16x8 __attribute__((ext_vector_type(8)));
typedef unsigned u32x4 __attribute__((ext_vector_type(4)));
typedef unsigned u32x2 __attribute__((ext_vector_type(2)));
typedef unsigned long long u64;

constexpr int D = 1024, NB = 8, SEQ = 4096, M = NB * SEQ, DFF = 2816, NMOD = 9 * D;
constexpr int DSA_N = 2304, DSA_NREAL = 2120;
constexpr int RW_N = 3584, RW_K = 2048, LORA_K = 384;
constexpr int LDS_BYTES = 147456;
constexpr int NTHREADS = 512;
constexpr size_t MiB = 1u << 20;
constexpr size_t WS_MOD = 0;
constexpr size_t WS_BAR = 768 * 1024;
constexpr int XB_LDS_OFF = 140000;
constexpr size_t WS_L1W = 1 * MiB;
constexpr size_t WS_WGU1 = WS_L1W;
constexpr size_t WS_WDN1 = WS_WGU1 + 22 * MiB;
constexpr size_t WS_WRWIN = WS_WDN1 + 11 * MiB;
constexpr size_t WS_WLORA = WS_WRWIN + 14 * MiB;
constexpr size_t WS_WRWOUT = WS_WLORA + 3 * MiB;
constexpr size_t WS_L0W = 53 * MiB;
constexpr size_t WS_WGU0 = WS_L0W;
constexpr size_t WS_WDN0 = WS_WGU0 + 22 * MiB;
constexpr size_t WS_WDSAIN = WS_WDN0 + 11 * MiB;
constexpr size_t WS_WDSAOUT = WS_WDSAIN + 5 * MiB;
constexpr size_t WS_U = 93 * MiB;
constexpr size_t WS_ACT = 157 * MiB;
constexpr size_t WS_QKVI = 157 * MiB;
constexpr size_t WS_QN = 301 * MiB;
constexpr size_t WS_KN = 365 * MiB;
constexpr size_t WS_VT = 381 * MiB;
constexpr size_t WS_IKN = 397 * MiB;
constexpr size_t WS_IW = 401 * MiB;
constexpr size_t WS_MASK = 402 * MiB;
constexpr size_t WS_A2 = 53 * MiB;
constexpr size_t WS_RK = 181 * MiB;
constexpr size_t WS_Y = 405 * MiB;
constexpr size_t WS_BIAS = 470 * MiB;
constexpr size_t WS_PART = 471 * MiB;
constexpr size_t WS_NEED = 473 * MiB;
constexpr int BV_GU0B = 0, BV_DSA = 8 * 5632, BV_GU1A = BV_DSA + 8 * 2304, BV_GU1B = BV_GU1A + 8 * 5632;

struct Args {
    const float* in[27];
    float* out; unsigned char* ws;
};
enum { I_X = 0, I_C, I_ADAW, I_ADAB, I_WGU, I_WDN, I_DSAIN, I_QNORM, I_KNORM, I_IKNORM, I_DSAOUT, I_MU, I_WRKV, I_W0, I_W1, I_W2, I_A0, I_A1, I_A2,
       I_G1, I_G2, I_KK, I_KA, I_RK, I_LNW, I_LNB, I_RWOUT };

__device__ __forceinline__ unsigned f2bf(float f) { unsigned u = __builtin_bit_cast(unsigned, f); return (u + 0x7fffu + ((u >> 16) & 1u)) >> 16; }
typedef __bf16 hwbf16x2 __attribute__((ext_vector_type(2)));
__device__ __forceinline__ unsigned pk2(float lo, float hi) { const f32x2 v = {lo, hi}; const hwbf16x2 b = __builtin_convertvector(v, hwbf16x2); return __builtin_bit_cast(unsigned, b); }
__device__ __forceinline__ float bf2f(unsigned short b) { return __builtin_bit_cast(float, (unsigned)b << 16); }
__device__ __forceinline__ float bflo(unsigned w) { return __builtin_bit_cast(float, w << 16); }
__device__ __forceinline__ float bfhi(unsigned w) { return __builtin_bit_cast(float, w & 0xffff0000u); }
__device__ __forceinline__ float wave_sum(float v) {
#pragma unroll
    for (int o = 1; o < 64; o <<= 1) v += __shfl_xor(v, o);
    return v;
}
template <int CTRL> __device__ __forceinline__ float dppf(float v) { return __builtin_bit_cast(float, __builtin_amdgcn_mov_dpp(__builtin_bit_cast(int, v), CTRL, 0xF, 0xF, true)); }
__device__ __forceinline__ float row16_sum(float v) {
    v += dppf<0xB1>(v);
    v += dppf<0x4E>(v);
    v += dppf<0x141>(v);
    v += dppf<0x140>(v);
    return v;
}
__device__ __forceinline__ float sigmoidf_(float x) { return __builtin_amdgcn_rcpf(1.f + __expf(-x)); }
__device__ __forceinline__ float siluf_(float x) { return x * sigmoidf_(x); }

struct XDesc { const float* W; int K, N, Npad; bf16* WT; int ldo, koff, rowoff, mode; const float* kscale; };
__device__ __forceinline__ void xpose_load(const XDesc& d, int tile, int tid, float (&v)[8]) {
    const int ntn = d.Npad / 64, kb = tile / ntn, nb = tile % ntn, k0 = kb * 64, n0 = nb * 64;
    const int nn = tid & 63, n = n0 + nn;
#pragma unroll
    for (int i = 0; i < 8; ++i) {
        const int kk = (tid >> 6) + 8 * i, k = k0 + kk;
        float x = (n < d.N) ? d.W[(size_t)k * d.N + n] : 0.f;
        if (d.kscale) x *= d.kscale[k];
        v[i] = x;
    }
}
__device__ __forceinline__ void xpose_lds(const float (&v)[8], float* scr, int tid) {
#pragma unroll
    for (int i = 0; i < 8; ++i) scr[((tid >> 6) + 8 * i) * 65 + (tid & 63)] = v[i];
}
__device__ __forceinline__ void xpose_write(const XDesc& d, int tile, const float* scr, int tid) {
    const int ntn = d.Npad / 64, kb = tile / ntn, nb = tile % ntn, k0 = kb * 64, n0 = nb * 64;
    const int nl = tid >> 3, kc = (tid & 7) * 8, n = n0 + nl;
    const int orow = d.rowoff + (d.mode == 1 ? ((n % DFF) * 2 + n / DFF) : n);
    const float* s = scr + kc * 65 + nl;
    u32x4 o; o.x = pk2(s[0], s[65]); o.y = pk2(s[2 * 65], s[3 * 65]); o.z = pk2(s[4 * 65], s[5 * 65]); o.w = pk2(s[6 * 65], s[7 * 65]);
    *(u32x4*)(d.WT + (size_t)orow * d.ldo + d.koff + k0 + kc) = o;
}
__device__ __forceinline__ int xd_tiles(int K, int Npad) { return (K / 64) * (Npad / 64); }

#define P0_DECODE(it_, d, r) do { r = (it_); d.mode = 0; d.kscale = nullptr; d.koff = 0; d.rowoff = 0;\
        if (r < 4 * T_GU) { const int w = r / T_GU; r -= w * T_GU; \
            d.W = a.in[I_WGU] + (size_t)w * D * 2 * DFF; d.K = D; d.N = 2 * DFF; d.Npad = 2 * DFF; d.ldo = D; d.mode = 1;\
            d.WT = (bf16*)(ws + (w < 2 ? WS_WGU0 + (size_t)w * 11 * MiB : WS_WGU1 + (size_t)(w - 2) * 11 * MiB));\
        } else if ((r -= 4 * T_GU) < 4 * T_DN) { const int w = r / T_DN; r -= w * T_DN;\
            d.W = a.in[I_WDN] + (size_t)w * DFF * D; d.K = DFF; d.N = D; d.Npad = D; d.ldo = DFF;\
            d.WT = (bf16*)(ws + (w < 2 ? WS_WDN0 + (size_t)w * 5767168 : WS_WDN1 + (size_t)(w - 2) * 5767168));\
        } else if ((r -= 4 * T_DN) < T_DIN) {\
            d.W = a.in[I_DSAIN]; d.K = D; d.N = DSA_NREAL; d.Npad = DSA_N; d.ldo = D; d.WT = (bf16*)(ws + WS_WDSAIN);\
        } else if ((r -= T_DIN) < T_SQ) {\
            d.W = a.in[I_DSAOUT]; d.K = D; d.N = D; d.Npad = D; d.ldo = D; d.WT = (bf16*)(ws + WS_WDSAOUT);\
        } else if ((r -= T_SQ) < 6 * T_SQ) { const int w = r / T_SQ; r -= w * T_SQ; const int i = w >> 1, sec = w & 1; \
            d.W = a.in[I_WRKV] + (size_t)i * D * D; d.K = D; d.N = D; d.Npad = D; d.ldo = RW_K; d.koff = sec * D; d.rowoff = i * D;\
            d.kscale = sec ? a.in[I_MU] + i * D : nullptr; d.WT = (bf16*)(ws + WS_WRWIN);\
        } else if ((r -= 6 * T_SQ) < 4 * T_L64) { const int w = r / T_L64; r -= w * T_L64; const int i = w >> 1, sec = w & 1; \
            d.W = a.in[i == 0 ? I_W1 : I_A1]; d.K = D; d.N = 64; d.Npad = 64; d.ldo = RW_K; d.koff = sec * D; d.rowoff = 3072 + 64 * i;\
            d.kscale = sec ? a.in[I_MU] + (3 + i) * D : nullptr; d.WT = (bf16*)(ws + WS_WRWIN);\
        } else if ((r -= 4 * T_L64) < 2 * T_G1) { const int sec = r / T_G1; r -= sec * T_G1;\
            d.W = a.in[I_G1]; d.K = D; d.N = 160; d.Npad = 384; d.ldo = RW_K; d.koff = sec * D; d.rowoff = 3200;\
            d.kscale = sec ? a.in[I_MU] + 5 * D : nullptr; d.WT = (bf16*)(ws + WS_WRWIN);\
        } else { r -= 2 * T_G1;\
            d.W = a.in[I_RWOUT]; d.K = D; d.N = D; d.Npad = D; d.ldo = D; d.WT = (bf16*)(ws + WS_WRWOUT);\
        } } while (0)
__device__ __forceinline__ void p0_prep(const Args& a, unsigned char* lds, int tid) {
    asm volatile("" : "+v"(tid));
    unsigned char* ws = a.ws;
    float* scr = (float*)lds;
    float* cs = (float*)(lds + 16640);
    float* red = (float*)(lds + 16640 + 32768);
    const int G = gridDim.x, bid = blockIdx.x;
    if (bid == 0) { unsigned* bw = (unsigned*)(ws + WS_BAR); for (int i = tid; i < 3456; i += NTHREADS) bw[i] = 0u; }
    constexpr int T_GU = 16 * 88, T_DN = 44 * 16, T_DIN = 16 * 36, T_SQ = 16 * 16, T_L64 = 16 * 1, T_G1 = 16 * 6;
    constexpr int NDESC = 4 + 4 + 1 + 1 + 6 + 2 + 2 + 2 + 1;
    int total = 4 * T_GU + 4 * T_DN + T_DIN + T_SQ + 6 * T_SQ + 4 * T_L64 + 2 * T_G1 + T_SQ;
    {
        XDesc d, dn; int r = 0, rn = 0; float v[8], vn[8];
        int it = bid;
        if (it < total) { P0_DECODE(it, d, r); xpose_load(d, r, tid, v); }
        while (it < total) {
            xpose_lds(v, scr, tid);
            __syncthreads();
            const int itn = it + G;
            if (itn < total) { P0_DECODE(itn, dn, rn); xpose_load(dn, rn, tid, vn); }
            xpose_write(d, r, scr, tid);
            __syncthreads();
            d = dn; r = rn; it = itn;
#pragma unroll
            for (int i = 0; i < 8; ++i) v[i] = vn[i];
        }
    }
    (void)NDESC;
    {
        bf16* WL = (bf16*)(ws + WS_WLORA);
        for (int idx = bid * NTHREADS + tid; idx < (LORA_K / 8) * 3072; idx += G * NTHREADS) {
            const int kg = idx / 3072, n = idx % 3072, blk = n >> 10, nn = n & 1023;
            float v[8];
#pragma unroll
            for (int j = 0; j < 8; ++j) { const int k = kg * 8 + j; float x = 0.f;
                if (blk == 0) { if (k < 64) x = a.in[I_W2][(size_t)k * D + nn]; }
                else if (blk == 1) { if (k >= 64 && k < 128) x = a.in[I_A2][(size_t)(k - 64) * D + nn]; }
                else { if (k >= 128 && k < 288) x = a.in[I_G2][(size_t)(k - 128) * D + nn]; }
                v[j] = x; }
            u32x4 o; o.x = pk2(v[0], v[1]); o.y = pk2(v[2], v[3]); o.z = pk2(v[4], v[5]); o.w = pk2(v[6], v[7]);
            *(u32x4*)(WL + (size_t)n * LORA_K + kg * 8) = o;
        }
    }
    if (bid < 288) {
        for (int i = tid; i < NB * D; i += NTHREADS) cs[i] = siluf_(a.in[I_C][i]);
        __syncthreads();
        const int lane = tid & 63, w = tid >> 6;
        float* MOD = (float*)(ws + WS_MOD);
        for (int tile = bid; tile < 288; tile += G) {
            const int l = tile / 144, n = (tile % 144) * 64 + lane;
            const float* wp = a.in[I_ADAW] + ((size_t)l * D + w * 128) * NMOD + n;
            float acc[8];
#pragma unroll
            for (int b = 0; b < 8; ++b) acc[b] = 0.f;
#pragma unroll 32
            for (int k = 0; k < 128; ++k) { const float wv = wp[(size_t)k * NMOD];
#pragma unroll
                for (int b = 0; b < 8; ++b) acc[b] += cs[b * D + w * 128 + k] * wv; }
#pragma unroll
            for (int b = 0; b < 8; ++b) red[(w * 8 + b) * 64 + lane] = acc[b];
            __syncthreads();
            { const int b = tid >> 6; float s = a.in[I_ADAB][l * NMOD + n];
#pragma unroll
              for (int ww = 0; ww < 8; ++ww) s += red[(ww * 8 + b) * 64 + lane];
              MOD[(size_t)(l * 8 + b) * NMOD + n] = s; }
            __syncthreads();
        }
    }
}

__device__ __forceinline__ void norm_row(const float* hrow, const float* sh, const float* sc, int lane, f32x4 (&u)[4]) {
    float ss = 0.f;
#pragma unroll
    for (int j = 0; j < 4; ++j) { u[j] = *(const f32x4*)(hrow + 4 * lane + 256 * j); ss += (u[j].x * u[j].x + u[j].y * u[j].y) + (u[j].z * u[j].z + u[j].w * u[j].w); }
    ss = wave_sum(ss);
    const float rstd = __builtin_amdgcn_rsqf(ss * (1.f / D) + 1e-6f);
#pragma unroll
    for (int j = 0; j < 4; ++j) { const f32x4 a = *(const f32x4*)(sc + 4 * lane + 256 * j), b = *(const f32x4*)(sh + 4 * lane + 256 * j);
        u[j] = (u[j] * rstd) * (a + 1.0f) + b; }
}
__device__ __forceinline__ void norm_phase(const float* h, const float* modl  , int idx  , bf16* U, int mode, int tid) {
    asm volatile("" : "+v"(tid));
    const int lane = tid & 63, gw = blockIdx.x * 8 + (tid >> 6), NGW = gridDim.x * 8;
    for (int row = gw; row < M; row += NGW) {
        const int b = row >> 12, t = row & (SEQ - 1);
        const float* sh = modl + (size_t)b * NMOD + (idx * 3) * D; const float* sc = sh + D;
        f32x4 u[4]; norm_row(h + (size_t)row * D, sh, sc, lane, u);
        if (mode == 0) {
#pragma unroll
            for (int j = 0; j < 4; ++j) { u32x2 o; o.x = pk2(u[j].x, u[j].y); o.y = pk2(u[j].z, u[j].w); *(u32x2*)(U + (size_t)row * D + 4 * lane + 256 * j) = o; }
        } else {
            f32x4 p[4];
            if (t > 0) norm_row(h + (size_t)(row - 1) * D, sh, sc, lane, p);
            else {
#pragma unroll
                for (int j = 0; j < 4; ++j) p[j] = (f32x4){0.f, 0.f, 0.f, 0.f};
            }
#pragma unroll
            for (int j = 0; j < 4; ++j) { u32x2 o; o.x = pk2(u[j].x, u[j].y); o.y = pk2(u[j].z, u[j].w); *(u32x2*)(U + (size_t)row * RW_K + 4 * lane + 256 * j) = o;
                const f32x4 x = p[j] - u[j]; u32x2 q; q.x = pk2(x.x, x.y); q.y = pk2(x.z, x.w); *(u32x2*)(U + (size_t)row * RW_K + D + 4 * lane + 256 * j) = q; }
        }
    }
}

__device__ __forceinline__ void bias_phase(unsigned char* ws, int tid) {
    asm volatile("" : "+v"(tid));
    const int lane = tid & 63, gw = blockIdx.x * 8 + (tid >> 6), NGW = gridDim.x * 8;
    const int r16 = lane & 15, kg = lane >> 4;
    const float* MOD = (const float*)(ws + WS_MOD); float* BV = (float*)(ws + WS_BIAS);
    for (int task = gw; task < 352 * 3 + 144; task += NGW) {
        int t = task; const bf16* Bt; const float* sh; float* dst; int N;
        if (t < 352) { Bt = (const bf16*)(ws + WS_WGU0 + 11 * MiB); sh = MOD + 6 * D; dst = BV + BV_GU0B; N = 5632; }
        else if ((t -= 352) < 144) { Bt = (const bf16*)(ws + WS_WDSAIN); sh = MOD + 3 * D; dst = BV + BV_DSA; N = 2304; }
        else if ((t -= 144) < 352) { Bt = (const bf16*)(ws + WS_WGU1); sh = MOD + (size_t)8 * NMOD; dst = BV + BV_GU1A; N = 5632; }
        else { t -= 352; Bt = (const bf16*)(ws + WS_WGU1 + 11 * MiB); sh = MOD + (size_t)8 * NMOD + 6 * D; dst = BV + BV_GU1B; N = 5632; }
        const int n0 = t * 16;
        const float* ap = sh + (size_t)(r16 & 7) * NMOD + 8 * kg;
        const bf16* bp = Bt + (size_t)(n0 + r16) * D + 8 * kg;
        f32x4 acc = (f32x4){0.f, 0.f, 0.f, 0.f};
#pragma unroll 8
        for (int s = 0; s < 32; ++s) {
            const f32x4 x0 = *(const f32x4*)(ap + 32 * s), x1 = *(const f32x4*)(ap + 32 * s + 4);
            u32x4 aw; aw.x = pk2(x0.x, x0.y); aw.y = pk2(x0.z, x0.w); aw.z = pk2(x1.x, x1.y); aw.w = pk2(x1.z, x1.w);
            if (r16 >= 8) aw = (u32x4){0u, 0u, 0u, 0u};
            const bf16x8 bw = *(const bf16x8*)(bp + 32 * s);
            acc = __builtin_amdgcn_mfma_f32_16x16x32_bf16(__builtin_bit_cast(bf16x8, aw), bw, acc, 0, 0, 0);
        }
        if (kg < 2) {
#pragma unroll
            for (int v = 0; v < 4; ++v) dst[(size_t)(4 * kg + v) * N + n0 + r16] = acc[v];
        }
    }
}

namespace pg8 {
template <bool FOLD> struct EpiSwiglu {
    static constexpr bool PERM = true, AFTER_DRAIN = false;
    bf16_t* O; int ldc; const float* part; const float* biasv  ;
    __device__ __forceinline__ void operator()(const f32x4 (&acc)[2][2][4][2], const Unit& u, int wr, int wc, int fr, int fq) const {
        const int row0 = u.pm * BM + wr * 64 + fr, col0 = u.pn * BM + wc * 32 + 8 * fq;
        f32x4 bv[2][2];
        if (FOLD) { const float* bp = biasv + (size_t)(u.pm >> 4) * (2 * DFF) + col0;
#pragma unroll
            for (int bj = 0; bj < 2; ++bj) { bv[bj][0] = *(const f32x4*)(bp + bj * HALF); bv[bj][1] = *(const f32x4*)(bp + bj * HALF + 4); } }
        float rs[8];
        if (FOLD) {
#pragma unroll
            for (int i = 0; i < 8; ++i) { const f32x4 t = *(const f32x4*)(part + (size_t)(row0 + (i >> 2) * HALF + (i & 3) * 16) * 16 + 4 * fq); rs[i] = (t.x + t.y) + (t.z + t.w); }
#pragma unroll
            for (int i = 0; i < 8; ++i) { float t = rs[i]; t += __shfl_xor(t, 16); t += __shfl_xor(t, 32); rs[i] = __builtin_amdgcn_rsqf(t * (1.f / 1024.f) + 1e-6f); }
        }
#pragma unroll
        for (int ai = 0; ai < 2; ++ai)
#pragma unroll
            for (int m = 0; m < 4; ++m) { const int row = row0 + ai * HALF + m * 16; bf16_t* rowp = O + (size_t)row * ldc;
                const float rstd = FOLD ? rs[ai * 4 + m] : 1.f;
#pragma unroll
                for (int bj = 0; bj < 2; ++bj) { f32x4 v0 = acc[ai][bj][m][0], v1 = acc[ai][bj][m][1];
                    if (FOLD) { v0 = v0 * rstd + bv[bj][0]; v1 = v1 * rstd + bv[bj][1]; }
                    const float o0 = siluf_(v0[0]) * v0[1], o1 = siluf_(v0[2]) * v0[3], o2 = siluf_(v1[0]) * v1[1], o3 = siluf_(v1[2]) * v1[3];
                    u32x2 w; w.x = cvt_pk_bf16(o0, o1); w.y = cvt_pk_bf16(o2, o3);
                    *(u32x2*)(rowp + ((col0 + bj * HALF) >> 1)) = w; } }
    }
};
template <bool FOLD, bool HALFSC> struct EpiResid {
    static constexpr bool PERM = false, AFTER_DRAIN = false;
    const float* base; float* out; const float* gate  ;
    bf16_t* U2; const float* scn  ; float* part;
    __device__ __forceinline__ void operator()(const f32x4 (&acc)[2][2][4][2], const Unit& u, int wr, int wc, int fr, int fq) const {
        const int row0 = u.pm * BM + wr * 64 + fr, col0 = u.pn * BM + wc * 32 + 4 * fq;
        const float* gp = gate + (size_t)(u.pm >> 4) * NMOD;
        f32x4 gv[2][2], sv[2][2];
#pragma unroll
        for (int bj = 0; bj < 2; ++bj)
#pragma unroll
            for (int n = 0; n < 2; ++n) { gv[bj][n] = *(const f32x4*)(gp + col0 + bj * HALF + n * 16) * (HALFSC ? 0.5f : 1.0f);
                if (FOLD) sv[bj][n] = *(const f32x4*)(scn + (size_t)(u.pm >> 4) * NMOD + col0 + bj * HALF + n * 16) + 1.0f; }
#pragma unroll
        for (int ai = 0; ai < 2; ++ai)
#pragma unroll
            for (int m = 0; m < 4; ++m) { const int row = row0 + ai * HALF + m * 16; const size_t off = (size_t)row * D + col0;
                float ssq = 0.f;
#pragma unroll
                for (int bj = 0; bj < 2; ++bj)
#pragma unroll
                    for (int n = 0; n < 2; ++n) { const f32x4 bs = *(const f32x4*)(base + off + bj * HALF + n * 16);
                        const f32x4 o = bs + gv[bj][n] * acc[ai][bj][m][n];
                        *(f32x4*)(out + off + bj * HALF + n * 16) = o;
                        if (FOLD) { ssq += (o.x * o.x + o.y * o.y) + (o.z * o.z + o.w * o.w); const f32x4 q = o * sv[bj][n];
                            u32x2 w; w.x = cvt_pk_bf16(q.x, q.y); w.y = cvt_pk_bf16(q.z, q.w); *(u32x2*)(U2 + off + bj * HALF + n * 16) = w; } }
                if (FOLD) { ssq += __shfl_xor(ssq, 16); ssq += __shfl_xor(ssq, 32);
                    if (fq == 0) part[(size_t)row * 16 + (u.pn & 3) * 4 + wc] = ssq; } }
    }
};
template <int MODE> struct EpiBf16 {
    static constexpr bool PERM = true, AFTER_DRAIN = false;
    bf16_t* O; int ldc; const float* p0; const float* p1;
    __device__ __forceinline__ void operator()(const f32x4 (&acc)[2][2][4][2], const Unit& u, int wr, int wc, int fr, int fq) const {
        const int row0 = u.pm * BM + wr * 64 + fr, col0 = u.pn * BM + wc * 32 + 8 * fq;
        float rs[8];
        if (MODE == 3) {
#pragma unroll
            for (int i = 0; i < 8; ++i) { const f32x4 t = *(const f32x4*)(p0 + (size_t)(row0 + (i >> 2) * HALF + (i & 3) * 16) * 16 + 4 * fq); rs[i] = (t.x + t.y) + (t.z + t.w); }
#pragma unroll
            for (int i = 0; i < 8; ++i) { float t = rs[i]; t += __shfl_xor(t, 16); t += __shfl_xor(t, 32); rs[i] = __builtin_amdgcn_rsqf(t * (1.f / 1024.f) + 1e-6f); }
        }
#pragma unroll
        for (int bj = 0; bj < 2; ++bj) {
            const int c = col0 + bj * HALF;
            f32x4 b0 = (f32x4){0.f, 0.f, 0.f, 0.f}, b1 = b0; int kind = 0;
            if (MODE == 1) { kind = (c >= 3072 && c < 3136) ? 1 : ((c >= 3200) ? 2 : 0); }
            if (MODE == 3) { b0 = *(const f32x4*)(p1 + (size_t)(u.pm >> 4) * ldc + c); b1 = *(const f32x4*)(p1 + (size_t)(u.pm >> 4) * ldc + c + 4); }
            if (MODE == 2) { if (c < 1024) { kind = 3; b0 = *(const f32x4*)(p0 + c); b1 = *(const f32x4*)(p0 + c + 4); } else { kind = 2; b0 = *(const f32x4*)(p1 + c - 1024); b1 = *(const f32x4*)(p1 + c - 1024 + 4); } }
#pragma unroll
            for (int ai = 0; ai < 2; ++ai)
#pragma unroll
                for (int m = 0; m < 4; ++m) { bf16_t* rowp = O + (size_t)(row0 + ai * HALF + m * 16) * ldc + c;
                    f32x4 v0, v1;
                    if (MODE == 3) { const float rstd = rs[ai * 4 + m]; v0 = acc[ai][bj][m][0] * rstd + b0; v1 = acc[ai][bj][m][1] * rstd + b1; }
                    else { v0 = acc[ai][bj][m][0] + b0; v1 = acc[ai][bj][m][1] + b1; }
                    if (MODE == 1 || MODE == 2) {
#pragma unroll
                        for (int e = 0; e < 4; ++e) {
                            if (kind == 1) { v0[e] = 2.f * sigmoidf_(2.f * v0[e]) - 1.f; v1[e] = 2.f * sigmoidf_(2.f * v1[e]) - 1.f; }
                            else if (kind == 2) { v0[e] = sigmoidf_(v0[e]); v1[e] = sigmoidf_(v1[e]); }
                            else if (kind == 3) { v0[e] = 0.60653066f * sigmoidf_(v0[e]); v1[e] = 0.60653066f * sigmoidf_(v1[e]); }
                        }
                    }
                    u32x4 w; w.x = cvt_pk_bf16(v0[0], v0[1]); w.y = cvt_pk_bf16(v0[2], v0[3]); w.z = cvt_pk_bf16(v1[0], v1[1]); w.w = cvt_pk_bf16(v1[2], v1[3]);
                    *(u32x4*)rowp = w; }
        }
    }
};
}

template <bool ALIGN = true, class Epi> __device__ __forceinline__ void run_gemm(unsigned char* lds, const bf16* A, int lda, const bf16* Bt, int Mrows, int N, int K, const Epi& E) {
    asm volatile("" : "+s"(A), "+s"(Bt), "+s"(K));
    pg8::Gemm g{A, Bt, Mrows, N, K, lda}; pg8::StaticOrder S; S.init(Mrows, N, (int)gridDim.x, (int)blockIdx.x);
    pg8::gemm_phase<Epi, pg8::StaticOrder, ALIGN, true>((PG8_LAS unsigned char*)lds, g, S, E);
}
#define XB_TMO      128
#define XB_XCNT(j)  (256  + 64 * (j))
#define XB_XSUB(j)  (1280 + 64 * (j))
#define XB_XGEN(j)  (2304 + 64 * (j))
#define XB_TOP      3328
#define XB_TOPGEN   3392
#define XCD_BAR_WORDS 3456
#define XB_SPIN_CAP (1u << 18)

__device__ __forceinline__ unsigned xb_ld(unsigned* p)              { return __hip_atomic_load(p, __ATOMIC_RELAXED, __HIP_MEMORY_SCOPE_AGENT); }
__device__ __forceinline__ unsigned xb_add(unsigned* p, unsigned v) { return __hip_atomic_fetch_add(p, v, __ATOMIC_RELAXED, __HIP_MEMORY_SCOPE_AGENT); }
__device__ __forceinline__ unsigned xb_xcc_id() { return (unsigned)__builtin_amdgcn_s_getreg((3 << 11) | 20) & 0xFu; }
#define XB_SPIN(cond, bar) do { unsigned _sp = 0; while (cond) { __builtin_amdgcn_s_sleep(1); \
    if ((++_sp & 255u) == 0u) { if (xb_ld(&(bar)[XB_TMO])) break; if (_sp > XB_SPIN_CAP) { atomicAdd(&(bar)[XB_TMO], 1u); break; } } } } while (0)

struct XcdBarrier {
    unsigned* bar; unsigned x;
    volatile LAS unsigned* st;
};

__device__ __forceinline__ XcdBarrier xcd_barrier_post(unsigned* bar, volatile LAS unsigned* st) {
    XcdBarrier b; b.bar = bar; b.x = xb_xcc_id(); b.st = st;
    if (threadIdx.x == 0) (void)xb_add(&bar[XB_XCNT(b.x)], 1u);
    return b;
}
__device__ __forceinline__ void xcd_barrier_complete(unsigned* bar, unsigned x, unsigned& nloc, unsigned& nx) {
    const unsigned G = gridDim.x * gridDim.y * gridDim.z;
    unsigned sum, cnt, mine, sp = 0u;
    for (;;) {
        sum = 0u; cnt = 0u; mine = 0u;
#pragma unroll
        for (unsigned j = 0; j < 16; ++j) { const unsigned c = xb_ld(&bar[XB_XCNT(j)]); sum += c; cnt += (c > 0u) ? 1u : 0u; mine = (j == x) ? c : mine; }
        if (sum == G) break;
        __builtin_amdgcn_s_sleep(1);
        if ((++sp & 255u) == 0u) { if (xb_ld(&bar[XB_TMO])) break; if (sp > XB_SPIN_CAP) { atomicAdd(&bar[XB_TMO], 1u); break; } }
    }
    nloc = mine > 0u ? mine : 1u; nx = cnt > 0u ? cnt : 1u;
}

__device__ __forceinline__ void xcd_barrier(const XcdBarrier& b) {
    asm volatile("s_waitcnt vmcnt(0)" ::: "memory");
    __syncthreads();
    if (threadIdx.x == 0) {
        unsigned* bar = b.bar;
        __builtin_amdgcn_s_waitcnt(0);
        unsigned nloc = b.st[0], nx = b.st[1];
        if (nloc == 0u) { xcd_barrier_complete(bar, b.x, nloc, nx); b.st[0] = nloc; b.st[1] = nx; }
        const unsigned old = xb_add(&bar[XB_XSUB(b.x)], 1u);
        const unsigned gen = old / nloc;
        if (old + 1u == (gen + 1u) * nloc) {
            __builtin_amdgcn_fence(__ATOMIC_RELEASE, "agent");
            asm volatile("s_waitcnt vmcnt(0)" ::: "memory");
            const unsigned og = xb_add(&bar[XB_TOP], 1u);
            const unsigned tg = og / nx;
            if (og + 1u == (tg + 1u) * nx) xb_add(&bar[XB_TOPGEN], 1u);
            else XB_SPIN(xb_ld(&bar[XB_TOPGEN]) == tg, bar);
            __builtin_amdgcn_fence(__ATOMIC_ACQUIRE, "agent");
            xb_add(&bar[XB_XGEN(b.x)], 1u);
            asm volatile("s_waitcnt vmcnt(0)" ::: "memory");
        } else {
            XB_SPIN(xb_ld(&bar[XB_XGEN(b.x)]) == gen, bar);
            __builtin_amdgcn_fence(__ATOMIC_ACQUIRE, "agent");
            asm volatile("s_waitcnt vmcnt(0)" ::: "memory");
        }
    }
    __syncthreads();
}

constexpr int QKVI_LD = DSA_N;
constexpr float QSCALE = 0.18033688011112042f;
constexpr float IWSCALE = 0.04419417382415922f;

__device__ __forceinline__ void dsa_prep(const Args& a, unsigned char* lds, int tid) {
    asm volatile("" : "+v"(tid));
    unsigned char* ws = a.ws;
    const bf16* QKVI = (const bf16*)(ws + WS_QKVI);
    bf16* QN = (bf16*)(ws + WS_QN); bf16* KN = (bf16*)(ws + WS_KN); bf16* VT = (bf16*)(ws + WS_VT); bf16* IKN = (bf16*)(ws + WS_IKN); float* IW = (float*)(ws + WS_IW);
    bf16* vt = (bf16*)lds;
    const int lane = tid & 63, w = tid >> 6, sub = lane & 15, grp = lane >> 4;
    const f32x4 qn = *(const f32x4*)(a.in[I_QNORM] + 4 * sub), kn = *(const f32x4*)(a.in[I_KNORM] + 4 * sub), ikn = *(const f32x4*)(a.in[I_IKNORM] + 4 * sub);
    for (int blk = blockIdx.x; blk < M / 64; blk += gridDim.x) {
        const int t0 = blk * 64, b = t0 >> 12, tt0 = t0 & (SEQ - 1);
#pragma unroll 4
        for (int i = 0; i < 8; ++i) {
            const int row = t0 + 8 * w + i;
            const bf16* src = QKVI + (size_t)row * QKVI_LD;
#pragma unroll
            for (int j = 0; j < 5; ++j) {
                const int hh = j * 4 + grp, col = hh * 64 + 4 * sub;
                const u32x2 x = *(const u32x2*)(src + col);
                f32x4 v = (f32x4){bflo(x.x), bfhi(x.x), bflo(x.y), bfhi(x.y)};
                float ss = (v.x * v.x + v.y * v.y) + (v.z * v.z + v.w * v.w);
                ss = row16_sum(ss);
                const float rstd = __builtin_amdgcn_rsqf(ss * (1.f / 64.f) + 1e-6f);
                if (j < 4) { v = v * rstd * qn * QSCALE; u32x2 o; o.x = pk2(v.x, v.y); o.y = pk2(v.z, v.w); *(u32x2*)(QN + (size_t)row * D + col) = o; }
                else { v = v * rstd * kn; u32x2 o; o.x = pk2(v.x, v.y); o.y = pk2(v.z, v.w); *(u32x2*)(KN + (size_t)row * 256 + (col - 1024)) = o; }
            }
            {
                const u32x2 x = *(const u32x2*)(src + 2048 + 4 * sub);
                f32x4 v = (f32x4){bflo(x.x), bfhi(x.x), bflo(x.y), bfhi(x.y)};
                float ss = (v.x * v.x + v.y * v.y) + (v.z * v.z + v.w * v.w);
                ss = row16_sum(ss);
                const float rstd = __builtin_amdgcn_rsqf(ss * (1.f / 64.f) + 1e-6f);
                v = v * rstd * ikn;
                if (grp == 0) { u32x2 o; o.x = pk2(v.x, v.y); o.y = pk2(v.z, v.w); *(u32x2*)(IKN + (size_t)row * 64 + 4 * sub) = o; }
                if (lane < 8) IW[(size_t)row * 8 + lane] = bf2f(src[2112 + lane]) * IWSCALE;
            }
        }
        for (int task = tid; task < 64 * 64; task += NTHREADS) {
            const int tok = task >> 6, c4 = task & 63;
            const u32x2 x = *(const u32x2*)(QKVI + (size_t)(t0 + tok) * QKVI_LD + 1280 + 4 * c4);
            vt[(4 * c4 + 0) * 72 + tok] = (bf16)(x.x & 0xffffu); vt[(4 * c4 + 1) * 72 + tok] = (bf16)(x.x >> 16);
            vt[(4 * c4 + 2) * 72 + tok] = (bf16)(x.y & 0xffffu); vt[(4 * c4 + 3) * 72 + tok] = (bf16)(x.y >> 16);
        }
        __syncthreads();
        {
            const int col = tid >> 1, half = tid & 1;
            bf16* dst = VT + ((size_t)(b * 4 + (col >> 6)) * 64 + (col & 63)) * SEQ + tt0 + half * 32;
#pragma unroll
            for (int i = 0; i < 4; ++i) *(u32x4*)(dst + 8 * i) = *(const u32x4*)(vt + col * 72 + half * 32 + 8 * i);
        }
        __syncthreads();
    }
}

__device__ __forceinline__ u64 cmp_ge_mask(unsigned v, unsigned c) { u64 m; asm("v_cmp_ge_u32_e64 %0, %1, %2" : "=s"(m) : "v"(v), "s"(c)); return m; }
__device__ __forceinline__ unsigned f2key(float f) { const unsigned u = __builtin_bit_cast(unsigned, f); return (u & 0x80000000u) ? ~u : (u | 0x80000000u); }

template <bool DO_SELECT> __device__ __forceinline__ void dsa_index(const Args& a, unsigned char* lds, int tid) {
    asm volatile("" : "+v"(tid));
    unsigned char* ws = a.ws;
    const bf16* QKVI = (const bf16*)(ws + WS_QKVI); const bf16* IKN = (const bf16*)(ws + WS_IKN); const float* IW = (const float*)(ws + WS_IW);
    u64* MASK = (u64*)(ws + WS_MASK);
    float* scl = (float*)lds;
    const int lane = tid & 63, w = __builtin_amdgcn_readfirstlane(tid >> 6), hi = lane >> 5, l32 = lane & 31;
    const int G = gridDim.x;
    for (int r = blockIdx.x; r < M / 8; r += G) {
        const int b = r >> 9; int qi = r & 511; if ((r >> 9) & 1) qi = 511 - qi;
        const int q0 = qi * 8, nch = (q0 >> 6) + 1;
        const size_t rowb = (size_t)b * SEQ;
        bf16x8 af[2][4];
#pragma unroll
        for (int rb = 0; rb < 2; ++rb)
#pragma unroll
            for (int ks = 0; ks < 4; ++ks)
                af[rb][ks] = *(const bf16x8*)(QKVI + (rowb + q0 + rb * 4 + (l32 >> 3)) * QKVI_LD + 1536 + (l32 & 7) * 64 + 16 * ks + 8 * hi);
        f32x4 iwv[8];
#pragma unroll
        for (int q = 0; q < 8; ++q) iwv[q] = *(const f32x4*)(IW + (rowb + q0 + q) * 8 + 4 * hi);
        for (int ch = w; ch < nch; ch += 8) {
            float part[2][8];
#pragma unroll
            for (int cb = 0; cb < 2; ++cb) {
                bf16x8 bfr[4];
#pragma unroll
                for (int ks = 0; ks < 4; ++ks) bfr[ks] = *(const bf16x8*)(IKN + (rowb + ch * 64 + cb * 32 + l32) * 64 + 16 * ks + 8 * hi);
#pragma unroll
                for (int rb = 0; rb < 2; ++rb) {
                    f32x16 acc;
#pragma unroll
                    for (int e = 0; e < 16; ++e) acc[e] = 0.f;
#pragma unroll
                    for (int ks = 0; ks < 4; ++ks) acc = __builtin_amdgcn_mfma_f32_32x32x16_bf16(af[rb][ks], bfr[ks], acc, 0, 0, 0);
#pragma unroll
                    for (int q4 = 0; q4 < 4; ++q4) {
                        float s = 0.f;
#pragma unroll
                        for (int e = 0; e < 4; ++e) s = fmaf(fmaxf(acc[4 * q4 + e], 0.f), iwv[rb * 4 + q4][e], s);
                        part[cb][rb * 4 + q4] = s;
                    }
                }
            }
#pragma unroll
            for (int q = 0; q < 8; ++q) {
                const float send = hi ? part[0][q] : part[1][q];
                const float recv = __shfl_xor(send, 32);
                float sc = (hi ? part[1][q] : part[0][q]) + recv;
                const int key = ch * 64 + lane;
                if (key > q0 + q) sc = -INFINITY;
                scl[q * SEQ + key] = sc;
            }
        }
        __syncthreads();
        if (DO_SELECT) {
            const int q = q0 + w, nreg = (q >> 6) + 1;
            unsigned u[64];
#pragma unroll
            for (int i = 0; i < 64; ++i) {
                unsigned v = 0u;
                if (i < nreg) { const int key = i * 64 + lane; const float f = scl[w * SEQ + key]; v = (key <= q) ? f2key(f) : 0u; }
                u[i] = v;
            }
            u64 myword = 0ull;
            if (q + 1 <= 256) {
#pragma unroll
                for (int i = 0; i < 64; ++i) { const u64 wd = __ballot(i * 64 + lane <= q); if (lane == i) myword = wd; }
            } else {
                unsigned prefix = 0u, ecand = 0u; bool exact = false;
                for (int bit = 31; bit >= 0; --bit) {
                    const unsigned cand = prefix | (1u << bit);
                    int cnt = 0;
#pragma unroll
                    for (int g = 0; g < 8; ++g) {
                        if (g * 8 < nreg) {
                            u64 m0, m1, m2, m3, m4, m5, m6, m7;
                            asm("v_cmp_ge_u32_e64 %0, %8, %16\n\tv_cmp_ge_u32_e64 %1, %9, %16\n\tv_cmp_ge_u32_e64 %2, %10, %16\n\tv_cmp_ge_u32_e64 %3, %11, %16\n\t"
                                "v_cmp_ge_u32_e64 %4, %12, %16\n\tv_cmp_ge_u32_e64 %5, %13, %16\n\tv_cmp_ge_u32_e64 %6, %14, %16\n\tv_cmp_ge_u32_e64 %7, %15, %16"
                                : "=&s"(m0), "=&s"(m1), "=&s"(m2), "=&s"(m3), "=&s"(m4), "=&s"(m5), "=&s"(m6), "=&s"(m7)
                                : "v"(u[g * 8 + 0]), "v"(u[g * 8 + 1]), "v"(u[g * 8 + 2]), "v"(u[g * 8 + 3]), "v"(u[g * 8 + 4]), "v"(u[g * 8 + 5]), "v"(u[g * 8 + 6]), "v"(u[g * 8 + 7]), "s"(cand));
                            cnt += (__builtin_popcountll(m0) + __builtin_popcountll(m1)) + (__builtin_popcountll(m2) + __builtin_popcountll(m3))
                                 + (__builtin_popcountll(m4) + __builtin_popcountll(m5)) + (__builtin_popcountll(m6) + __builtin_popcountll(m7));
                        }
                    }
                    if (cnt == 256) { exact = true; ecand = cand; break; }
                    if (cnt > 256) prefix = cand;
                }
                if (exact) {
#pragma unroll
                    for (int i = 0; i < 64; ++i) { const u64 wd = __ballot(u[i] >= ecand); if (lane == i) myword = wd; }
                } else {
                    const unsigned T = prefix;
                    int ngt = 0;
#pragma unroll
                    for (int i = 0; i < 64; ++i) ngt += __builtin_popcountll(__ballot(u[i] > T));
                    int need = 256 - ngt;
#pragma unroll
                    for (int i = 0; i < 64; ++i) {
                        const u64 gt = __ballot(u[i] > T); u64 eq = __ballot(u[i] == T);
                        while (__builtin_popcountll(eq) > need) eq &= ~(1ull << (63 - __builtin_clzll(eq)));
                        need -= __builtin_popcountll(eq);
                        const u64 wd = gt | eq; if (lane == i) myword = wd;
                    }
                }
            }
            MASK[(rowb + q) * 64 + lane] = myword;
        }
        __syncthreads();
    }
}

template <int PV> __device__ __forceinline__ void dsa_attn(const Args& a, unsigned char* lds, int tid) {
    asm volatile("" : "+v"(tid));
    unsigned char* ws = a.ws;
    const bf16* QN = (const bf16*)(ws + WS_QN); const bf16* KN = (const bf16*)(ws + WS_KN); const bf16* VT = (const bf16*)(ws + WS_VT);
    const u64* MASK = (const u64*)(ws + WS_MASK);
    bf16* O = (bf16*)(ws + (PV == 0 ? WS_QN : WS_U));
    bf16* ksm = (bf16*)lds;
    bf16* vsm = (bf16*)(lds + 4 * 64 * 72 * 2);
    const int lane = tid & 63, w = __builtin_amdgcn_readfirstlane(tid >> 6), hi = lane >> 5, l32 = lane & 31;
    const int srow = tid >> 3, sc16 = tid & 7;
    float nB;
    { float mq = fabsf(a.in[I_QNORM][lane]), mk = fabsf(a.in[I_KNORM][lane]);
#pragma unroll
      for (int o = 1; o < 64; o <<= 1) { mq = fmaxf(mq, __shfl_xor(mq, o)); mk = fmaxf(mk, __shfl_xor(mk, o)); }
      nB = -(64.0f * QSCALE * 1.02f) * mq * mk; }
    for (int c = blockIdx.x; c < 256; c += gridDim.x)
    for (int k = 0; k < 8; ++k) {
        const int bg = (c >> 6) + 4 * k, b = bg >> 2, g = bg & 3;
        int qt = c & 63; if (k & 1) qt = 63 - qt;
        const int hq = g * 4 + (w & 3), qb = qt * 64 + (w >> 2) * 32 + l32;
        const size_t rowb = (size_t)b * SEQ;
        const int ntile = qt + 1;
        bf16x8 qf[4];
#pragma unroll
        for (int ks = 0; ks < 4; ++ks) qf[ks] = *(const bf16x8*)(QN + (rowb + qb) * D + hq * 64 + 16 * ks + 8 * hi);
        const bf16* kg = KN + (rowb + srow) * 256 + g * 64 + sc16 * 8;
        const bf16* vg = VT + ((size_t)(b * 4 + g) * 64 + srow) * SEQ + sc16 * 8;
        const u64* mrow = MASK + (rowb + qb) * 64;
        u32x4 kr0 = *(const u32x4*)kg, vr0 = *(const u32x4*)vg, kr1 = kr0, vr1 = vr0;
        if (ntile > 1) { kr1 = *(const u32x4*)(kg + (size_t)64 * 256); vr1 = *(const u32x4*)(vg + 64); }
        *(u32x4*)(ksm + srow * 72 + sc16 * 8) = kr0; *(u32x4*)(vsm + srow * 72 + sc16 * 8) = vr0;
        *(u32x4*)(ksm + 64 * 72 + srow * 72 + sc16 * 8) = kr1; *(u32x4*)(vsm + 64 * 72 + srow * 72 + sc16 * 8) = vr1;
        __syncthreads();
        f32x16 o0, o1;
#pragma unroll
        for (int e = 0; e < 16; ++e) { o0[e] = 0.f; o1[e] = 0.f; }
        float lsum = 0.f;
        u64 mwa = mrow[0], mwb = (ntile > 1) ? mrow[1] : 0ull;
#define ATT_QK(KB_, P0, P1) do { const bf16* kb_ = (KB_); \
            _Pragma("unroll") for (int e = 0; e < 16; ++e) { P0[e] = nB; P1[e] = nB; } \
            __builtin_amdgcn_s_setprio(1); \
            if (PV != 4) _Pragma("unroll") for (int ks = 0; ks < 4; ++ks) { \
                const bf16x8 ka = *(const bf16x8*)(kb_ + l32 * 72 + 16 * ks + 8 * hi); \
                const bf16x8 kc = *(const bf16x8*)(kb_ + (32 + l32) * 72 + 16 * ks + 8 * hi); \
                P0 = __builtin_amdgcn_mfma_f32_32x32x16_bf16(ka, qf[ks], P0, 0, 0, 0); \
                P1 = __builtin_amdgcn_mfma_f32_32x32x16_bf16(kc, qf[ks], P1, 0, 0, 0); } \
            __builtin_amdgcn_s_setprio(0); } while (0)
#define ATT_SM(MW_, P0, P1) do { const u64 mw = (MW_); \
            const unsigned m0 = (unsigned)mw >> (4 * hi), m1 = (unsigned)(mw >> 32) >> (4 * hi); \
            float ps = 0.f, ps2 = 0.f; \
            if (PV != 2) _Pragma("unroll") for (int v = 0; v < 16; ++v) { \
                const int cbit = 8 * (v >> 2) + (v & 3); \
                int t0, t1; asm("v_bfe_i32 %0, %1, %2, 1" : "=v"(t0) : "v"(m0), "n"(cbit)); asm("v_bfe_i32 %0, %1, %2, 1" : "=v"(t1) : "v"(m1), "n"(cbit)); \
                P0[v] = __builtin_bit_cast(float, __builtin_bit_cast(int, __builtin_amdgcn_exp2f(P0[v])) & t0); \
                P1[v] = __builtin_bit_cast(float, __builtin_bit_cast(int, __builtin_amdgcn_exp2f(P1[v])) & t1); \
                asm("v_add_f32 %0, %1, %0" : "+v"(ps) : "v"(P0[v])); asm("v_add_f32 %0, %1, %0" : "+v"(ps2) : "v"(P1[v])); } \
            lsum += ps + ps2; } while (0)
#define ATT_PV(VB_, P0, P1) do { const bf16* vb_ = (VB_); __builtin_amdgcn_s_setprio(1); \
            if (PV == 3) { lsum += P0[0] + P1[5]; } else \
            _Pragma("unroll") for (int kb = 0; kb < 2; ++kb) \
            _Pragma("unroll") for (int s = 0; s < 2; ++s) { \
                    u32x4 pb; \
                    if (kb == 0) { pb.x = pk2(P0[8 * s + 0], P0[8 * s + 1]); pb.y = pk2(P0[8 * s + 2], P0[8 * s + 3]); pb.z = pk2(P0[8 * s + 4], P0[8 * s + 5]); pb.w = pk2(P0[8 * s + 6], P0[8 * s + 7]); } \
                    else         { pb.x = pk2(P1[8 * s + 0], P1[8 * s + 1]); pb.y = pk2(P1[8 * s + 2], P1[8 * s + 3]); pb.z = pk2(P1[8 * s + 4], P1[8 * s + 5]); pb.w = pk2(P1[8 * s + 6], P1[8 * s + 7]); } \
                    const bf16x8 pbv = __builtin_bit_cast(bf16x8, pb); \
                    const int base = kb * 32 + 16 * s + 4 * hi; \
                    { const u32x2 lo = *(const u32x2*)(vb_ + l32 * 72 + base), hi2 = *(const u32x2*)(vb_ + l32 * 72 + base + 8); \
                      const u32x4 va = (u32x4){lo.x, lo.y, hi2.x, hi2.y}; \
                      o0 = __builtin_amdgcn_mfma_f32_32x32x16_bf16(__builtin_bit_cast(bf16x8, va), pbv, o0, 0, 0, 0); } \
                    { const u32x2 lo = *(const u32x2*)(vb_ + (32 + l32) * 72 + base), hi2 = *(const u32x2*)(vb_ + (32 + l32) * 72 + base + 8); \
                      const u32x4 va = (u32x4){lo.x, lo.y, hi2.x, hi2.y}; \
                      o1 = __builtin_amdgcn_mfma_f32_32x32x16_bf16(__builtin_bit_cast(bf16x8, va), pbv, o1, 0, 0, 0); } } \
        __builtin_amdgcn_s_setprio(0); } while (0)
        for (int j = 0; j < ntile; j += 2) {
            const int set = (j >> 1) & 1;
            const bool have2 = (j + 1 < ntile), more0 = (j + 2 < ntile), more1 = (j + 3 < ntile);
            if (more0) { kr0 = *(const u32x4*)(kg + (size_t)(j + 2) * 64 * 256); vr0 = *(const u32x4*)(vg + (j + 2) * 64); }
            if (more1) { kr1 = *(const u32x4*)(kg + (size_t)(j + 3) * 64 * 256); vr1 = *(const u32x4*)(vg + (j + 3) * 64); }
            const u64 mw0 = mwa, mw1 = mwb;
            if (more0) mwa = mrow[j + 2];
            if (more1) mwb = mrow[j + 3];
            const bf16* kA = ksm + (2 * set) * 64 * 72; const bf16* vA = vsm + (2 * set) * 64 * 72;
            const bf16* kB = kA + 64 * 72; const bf16* vB = vA + 64 * 72;
            f32x16 pa0, pa1;
            if (have2) {
                f32x16 pb0, pb1;
                if (w < 4) {
                    ATT_QK(kA, pa0, pa1); ATT_QK(kB, pb0, pb1); ATT_SM(mw0, pa0, pa1); ATT_PV(vA, pa0, pa1); ATT_SM(mw1, pb0, pb1); ATT_PV(vB, pb0, pb1);
                } else {
                    ATT_QK(kA, pa0, pa1); ATT_SM(mw0, pa0, pa1); ATT_QK(kB, pb0, pb1); ATT_PV(vA, pa0, pa1); ATT_SM(mw1, pb0, pb1); ATT_PV(vB, pb0, pb1);
                }
            } else { ATT_QK(kA, pa0, pa1); ATT_SM(mw0, pa0, pa1); ATT_PV(vA, pa0, pa1); }
            if (more0) { *(u32x4*)(ksm + (2 * (set ^ 1)) * 64 * 72 + srow * 72 + sc16 * 8) = kr0; *(u32x4*)(vsm + (2 * (set ^ 1)) * 64 * 72 + srow * 72 + sc16 * 8) = vr0; }
            if (more1) { *(u32x4*)(ksm + (2 * (set ^ 1) + 1) * 64 * 72 + srow * 72 + sc16 * 8) = kr1; *(u32x4*)(vsm + (2 * (set ^ 1) + 1) * 64 * 72 + srow * 72 + sc16 * 8) = vr1; }
            __syncthreads();
        }
#undef ATT_QK
#undef ATT_SM
#undef ATT_PV
        const float ltot = lsum + __shfl_xor(lsum, 32);
        const float inv = 1.0f / ltot;
        bf16* orow = O + (rowb + qb) * D + hq * 64 + 4 * hi;
#pragma unroll
        for (int v4 = 0; v4 < 4; ++v4) {
            u32x2 x; x.x = pk2(o0[4 * v4] * inv, o0[4 * v4 + 1] * inv); x.y = pk2(o0[4 * v4 + 2] * inv, o0[4 * v4 + 3] * inv);
            *(u32x2*)(orow + 8 * v4) = x;
            u32x2 y; y.x = pk2(o1[4 * v4] * inv, o1[4 * v4 + 1] * inv); y.y = pk2(o1[4 * v4 + 2] * inv, o1[4 * v4 + 3] * inv);
            *(u32x2*)(orow + 32 + 8 * v4) = y;
        }
    }
}

__device__ __forceinline__ void dsa_mixer(const Args& a, unsigned char* lds, const XcdBarrier& bar, const float* modl, int tid) {
    unsigned char* ws = a.ws;
    bf16* U = (bf16*)(ws + WS_U);
    float* PART = (float*)(ws + WS_PART); const float* BV = (const float*)(ws + WS_BIAS);
    { pg8::EpiBf16<3> E{(bf16*)(ws + WS_QKVI), DSA_N, PART, BV + BV_DSA}; run_gemm(lds, U, D, (const bf16*)(ws + WS_WDSAIN), M, DSA_N, D, E); }
    xcd_barrier(bar);
    for (int rep = 0; rep < REP_DPREP; ++rep) { dsa_prep(a, lds, tid); xcd_barrier(bar); }
#if defined(PROBE_NOSEL)
    dsa_index<false>(a, lds, tid); xcd_barrier(bar);
#endif
    for (int rep = 0; rep < REP_INDEX; ++rep) { dsa_index<true>(a, lds, tid); xcd_barrier(bar); }
#if defined(PROBE_ATTN)
    dsa_attn<PROBE_ATTN>(a, lds, tid); xcd_barrier(bar);
#endif
    dsa_attn<0>(a, lds, tid); xcd_barrier(bar);
    { pg8::EpiResid<true, false> E{a.out, a.out, modl + 5 * D, U, modl + 7 * D, PART}; run_gemm(lds, (const bf16*)(ws + WS_QN), D, (const bf16*)(ws + WS_WDSAOUT), M, D, D, E); }
    xcd_barrier(bar);
}
__device__ __forceinline__ float afma(float a, float b, float c) { float d; asm("v_fma_f32 %0, %1, %2, %3" : "=v"(d) : "v"(a), "v"(b), "v"(c)); return d; }
__device__ __forceinline__ float amul(float a, float b) { float d; asm("v_mul_f32 %0, %1, %2" : "=v"(d) : "v"(a), "v"(b)); return d; }
constexpr int EA_LD = 2048;
template <int PMODE> __device__ __forceinline__ void rwkv_scan(const Args& a, unsigned char* lds, int tid) {
    asm volatile("" : "+v"(tid));
    unsigned char* ws = a.ws;
    const bf16* RK = (const bf16*)(ws + WS_RK); const bf16* EA = (const bf16*)(ws + WS_A2); bf16* Y = (bf16*)(ws + WS_Y);
    float* vecs = (float*)lds;
    float* ybuf = (float*)(lds + 2 * 6 * 32 * 64 * 4);
    const int lane = tid & 63, w = __builtin_amdgcn_readfirstlane(tid >> 6), slice = lane & 15, rin = w * 4 + (lane >> 4);
    const int ts = tid >> 4, cgp = tid & 15;
    for (int unit = blockIdx.x; unit < 256; unit += gridDim.x) {
        const int chain = unit >> 1, half = unit & 1, b = chain >> 4, h = chain & 15;
        const size_t rowb = (size_t)b * SEQ;
        const f32x4 kkp = *(const f32x4*)(a.in[I_KK] + h * 64 + 4 * cgp), kap = *(const f32x4*)(a.in[I_KA] + h * 64 + 4 * cgp);
        u32x2 rr, rk, rv, re, ra;
#define SCAN_LOAD(c) do { const size_t row_ = rowb + (c) * 32 + ts; const bf16* p_ = RK + row_ * RW_N + h * 64 + 4 * cgp; \
            rr = *(const u32x2*)p_; rk = *(const u32x2*)(p_ + 1024); rv = *(const u32x2*)(p_ + 2048); \
            const bf16* q_ = EA + row_ * EA_LD + h * 64 + 4 * cgp; re = *(const u32x2*)q_; ra = *(const u32x2*)(q_ + 1024); } while (0)
#define SCAN_STORE(buf) do { float* base_ = vecs + (buf) * 6 * 2048 + ts * 64 + 4 * cgp; \
            const f32x4 r4 = (f32x4){bflo(rr.x), bfhi(rr.x), bflo(rr.y), bfhi(rr.y)}, k4 = (f32x4){bflo(rk.x), bfhi(rk.x), bflo(rk.y), bfhi(rk.y)}; \
            const f32x4 v4 = (f32x4){bflo(rv.x), bfhi(rv.x), bflo(rv.y), bfhi(rv.y)}, e4 = (f32x4){bflo(re.x), bfhi(re.x), bflo(re.y), bfhi(re.y)}; \
            const f32x4 a4 = (f32x4){bflo(ra.x), bfhi(ra.x), bflo(ra.y), bfhi(ra.y)}; \
            f32x4 w4; w4.x = __expf(-e4.x); w4.y = __expf(-e4.y); w4.z = __expf(-e4.z); w4.w = __expf(-e4.w); \
            const f32x4 kraw = k4 * kkp; float ss_ = (kraw.x * kraw.x + kraw.y * kraw.y) + (kraw.z * kraw.z + kraw.w * kraw.w); ss_ = row16_sum(ss_); \
            const float inv_ = __builtin_amdgcn_rsqf(fmaxf(ss_, 1e-24f)); const f32x4 kkn = kraw * inv_; \
            const f32x4 kt = k4 * ((a4 - 1.0f) * kap + 1.0f); const f32x4 bv = kkn * a4; \
            *(f32x4*)(base_) = r4; *(f32x4*)(base_ + 2048) = w4; *(f32x4*)(base_ + 2 * 2048) = kt; *(f32x4*)(base_ + 3 * 2048) = -kkn; \
            *(f32x4*)(base_ + 4 * 2048) = bv; *(f32x4*)(base_ + 5 * 2048) = v4; } while (0)
        SCAN_LOAD(0); SCAN_STORE(0);
        __syncthreads();
        float s0 = 0.f, s1 = 0.f, s2 = 0.f, s3 = 0.f;
        for (int c = 0; c < SEQ / 32; ++c) {
            const int buf = c & 1;
            if (c + 1 < SEQ / 32) SCAN_LOAD(c + 1);
            if (PMODE != 1) {
                const float* vb = vecs + buf * 6 * 2048 + 4 * slice;
                const float* vv = vecs + buf * 6 * 2048 + 5 * 2048 + half * 32 + rin;
                float* yb = ybuf + buf * 4096 + rin * 4 + (slice >> 2);
                f32x4 r4 = *(const f32x4*)(vb), w4 = *(const f32x4*)(vb + 2048), k4 = *(const f32x4*)(vb + 2 * 2048);
                f32x4 n4 = *(const f32x4*)(vb + 3 * 2048), b4 = *(const f32x4*)(vb + 4 * 2048);
                float v1 = *vv;
#pragma unroll 8
                for (int t = 0; t < 32; ++t) {
                    const int tn = (t + 1) & 31;
                    const f32x4 r4n = *(const f32x4*)(vb + tn * 64), w4n = *(const f32x4*)(vb + 2048 + tn * 64), k4n = *(const f32x4*)(vb + 2 * 2048 + tn * 64);
                    const f32x4 n4n = *(const f32x4*)(vb + 3 * 2048 + tn * 64), b4n = *(const f32x4*)(vb + 4 * 2048 + tn * 64);
                    const float v1n = vv[tn * 64];
                    float sa = afma(s1, n4.y, amul(s0, n4.x)) + afma(s3, n4.w, amul(s2, n4.z));
                    sa = row16_sum(sa);
                    s0 = afma(s0, w4.x, amul(b4.x, sa)); s1 = afma(s1, w4.y, amul(b4.y, sa)); s2 = afma(s2, w4.z, amul(b4.z, sa)); s3 = afma(s3, w4.w, amul(b4.w, sa));
                    s0 = afma(k4.x, v1, s0); s1 = afma(k4.y, v1, s1); s2 = afma(k4.z, v1, s2); s3 = afma(k4.w, v1, s3);
                    float y = afma(s1, r4.y, amul(s0, r4.x)) + afma(s3, r4.w, amul(s2, r4.z));
                    y += dppf<0xB1>(y); y += dppf<0x4E>(y);
                    yb[t * 128] = y;
                    r4 = r4n; w4 = w4n; k4 = k4n; n4 = n4n; b4 = b4n; v1 = v1n;
                }
            }
            if (c + 1 < SEQ / 32) SCAN_STORE(buf ^ 1);
            __syncthreads();
            {
                const f32x4 ya = *(const f32x4*)(ybuf + buf * 4096 + ts * 128 + 8 * cgp), yb4 = *(const f32x4*)(ybuf + buf * 4096 + ts * 128 + 8 * cgp + 4);
                *(unsigned*)(Y + (rowb + c * 32 + ts) * D + h * 64 + half * 32 + 2 * cgp) = pk2((ya.x + ya.y) + (ya.z + ya.w), (yb4.x + yb4.y) + (yb4.z + yb4.w));
            }
        }
        __syncthreads();
#undef SCAN_LOAD
#undef SCAN_STORE
    }
}

__device__ __forceinline__ void rwkv_post(const Args& a, int tid) {
    asm volatile("" : "+v"(tid));
    unsigned char* ws = a.ws;
    const bf16* RK = (const bf16*)(ws + WS_RK); const bf16* EA = (const bf16*)(ws + WS_A2); bf16* Y = (bf16*)(ws + WS_Y);
    const int lane = tid & 63, sub = lane & 15, grp = lane >> 4;
    const int gw = blockIdx.x * 8 + (tid >> 6), NGW = gridDim.x * 8;
    for (int row = gw; row < M; row += NGW) {
#pragma unroll
        for (int pass = 0; pass < 4; ++pass) {
            const int c = (pass * 4 + grp) * 64 + 4 * sub;
            const u32x2 yy = *(const u32x2*)(Y + (size_t)row * D + c);
            const bf16* p = RK + (size_t)row * RW_N + c;
            const u32x2 rr = *(const u32x2*)p, rk = *(const u32x2*)(p + 1024), rv = *(const u32x2*)(p + 2048);
            const u32x2 gg = *(const u32x2*)(EA + (size_t)row * EA_LD + c), aa = *(const u32x2*)(EA + (size_t)row * EA_LD + 1024 + c);
            const f32x4 y4 = (f32x4){bflo(yy.x), bfhi(yy.x), bflo(yy.y), bfhi(yy.y)};
            const f32x4 r4 = (f32x4){bflo(rr.x), bfhi(rr.x), bflo(rr.y), bfhi(rr.y)}, k4 = (f32x4){bflo(rk.x), bfhi(rk.x), bflo(rk.y), bfhi(rk.y)};
            const f32x4 v4 = (f32x4){bflo(rv.x), bfhi(rv.x), bflo(rv.y), bfhi(rv.y)}, g4 = (f32x4){bflo(gg.x), bfhi(gg.x), bflo(gg.y), bfhi(gg.y)};
            const f32x4 a4 = (f32x4){bflo(aa.x), bfhi(aa.x), bflo(aa.y), bfhi(aa.y)};
            const f32x4 kap = *(const f32x4*)(a.in[I_KA] + c), rkp = *(const f32x4*)(a.in[I_RK] + c), lw = *(const f32x4*)(a.in[I_LNW] + c), lb = *(const f32x4*)(a.in[I_LNB] + c);
            const float mean = row16_sum((y4.x + y4.y) + (y4.z + y4.w)) * (1.f / 64.f);
            const f32x4 d4 = y4 - mean;
            const float var = row16_sum((d4.x * d4.x + d4.y * d4.y) + (d4.z * d4.z + d4.w * d4.w)) * (1.f / 64.f);
            const float rstd = __builtin_amdgcn_rsqf(var + 64e-5f);
            const f32x4 kt = k4 * ((a4 - 1.0f) * kap + 1.0f);
            const f32x4 rkk = r4 * kt * rkp;
            const float sd = row16_sum((rkk.x + rkk.y) + (rkk.z + rkk.w));
            const f32x4 o = ((d4 * rstd) * lw + lb + v4 * sd) * g4;
            u32x2 ov; ov.x = pk2(o.x, o.y); ov.y = pk2(o.z, o.w);
            *(u32x2*)(Y + (size_t)row * D + c) = ov;
        }
    }
}

__device__ __forceinline__ void rwkv_mixer(const Args& a, unsigned char* lds, const XcdBarrier& bar, const float* modl, int tid) {
    unsigned char* ws = a.ws;
    bf16* A2 = (bf16*)(ws + WS_A2); bf16* RK = (bf16*)(ws + WS_RK); bf16* Y = (bf16*)(ws + WS_Y);
    const bf16* WL = (const bf16*)(ws + WS_WLORA);
    norm_phase(a.out, modl, 1, A2, 1, tid);
    xcd_barrier(bar);
    for (int rep = 0; rep < REP_RWIN; ++rep) { pg8::EpiBf16<1> E{RK, RW_N, nullptr, nullptr}; run_gemm(lds, A2, RW_K, (const bf16*)(ws + WS_WRWIN), M, RW_N, RW_K, E); xcd_barrier(bar); }
    { pg8::EpiBf16<2> E{A2, EA_LD, a.in[I_W0], a.in[I_A0]}; run_gemm(lds, RK + 3072, RW_N, WL, M, 2048, LORA_K, E); }
    xcd_barrier(bar);
    #if defined(PROBE_SCAN_STAGE)
    rwkv_scan<1>(a, lds, tid); xcd_barrier(bar);
#endif
    for (int rep = 0; rep < REP_SCAN; ++rep) { rwkv_scan<0>(a, lds, tid); xcd_barrier(bar); }
    { pg8::EpiBf16<0> E{A2, EA_LD, nullptr, nullptr}; run_gemm(lds, RK + 3072, RW_N, WL + (size_t)2048 * LORA_K, M, 1024, LORA_K, E); }
    xcd_barrier(bar);
    rwkv_post(a, tid);
    xcd_barrier(bar);
    { pg8::EpiResid<true, false> E{a.out, a.out, modl + 5 * D, (bf16*)(ws + WS_U), modl + 7 * D, (float*)(ws + WS_PART)}; run_gemm(lds, Y, D, (const bf16*)(ws + WS_WRWOUT), M, D, D, E); }
    xcd_barrier(bar);
}

#ifndef REP_P0
#define REP_P0 1
#endif
#ifndef REP_NORM
#define REP_NORM 1
#endif
#ifndef REP_DOWN
#define REP_DOWN 1
#endif
#ifndef REP_GU
#define REP_GU 1
#endif
#ifndef ENABLE_DSA
#define ENABLE_DSA 1
#endif
#ifndef ENABLE_RWKV
#define ENABLE_RWKV 1
#endif
template <int L> __device__ __forceinline__ void layer_body(const Args& a, unsigned char* lds, const XcdBarrier& bar, int tid) {
    unsigned char* ws = a.ws;
    const float* MOD = (const float*)(ws + WS_MOD);
    bf16* U = (bf16*)(ws + WS_U);
    bf16* ACT = (bf16*)(ws + WS_ACT);
    float* H = a.out;
    float* PART = (float*)(ws + WS_PART); const float* BV = (const float*)(ws + WS_BIAS);
#define GSYNC() xcd_barrier(bar)

        const float* modl = MOD + (size_t)L * 8 * NMOD;
        const bf16* wgu0 = (const bf16*)(ws + (L == 0 ? WS_WGU0 : WS_WGU1));
        const bf16* wdn0 = (const bf16*)(ws + (L == 0 ? WS_WDN0 : WS_WDN1));
        if (L == 0) { for (int rep = 0; rep < REP_GU; ++rep) { pg8::EpiSwiglu<false> E{ACT, DFF, nullptr, nullptr}; run_gemm(lds, U, D, wgu0, M, 2 * DFF, D, E); GSYNC(); } }
        else { pg8::EpiSwiglu<true> E{ACT, DFF, PART, BV + BV_GU1A}; run_gemm(lds, U, D, wgu0, M, 2 * DFF, D, E); GSYNC(); }
        if (L == 0) {
            for (int rep = 0; rep < REP_DOWN; ++rep) { pg8::EpiResid<true, true> E{a.in[I_X], H, modl + 2 * D, U, modl + 4 * D, PART}; run_gemm(lds, ACT, DFF, wdn0, M, D, DFF, E); GSYNC(); }
            dsa_mixer(a, lds, bar, modl, tid);
        } else {
            { pg8::EpiResid<false, true> E{H, H, modl + 2 * D, nullptr, nullptr, nullptr}; run_gemm(lds, ACT, DFF, wdn0, M, D, DFF, E); }
            GSYNC();
            rwkv_mixer(a, lds, bar, modl, tid);
        }
        { pg8::EpiSwiglu<true> E{ACT, DFF, PART, BV + (L == 0 ? BV_GU0B : BV_GU1B)}; run_gemm(lds, U, D, wgu0 + (size_t)2 * DFF * D, M, 2 * DFF, D, E); }
        GSYNC();
        if (L == 0) { pg8::EpiResid<true, true> E{H, H, modl + 8 * D, U, MOD + (size_t)8 * NMOD + D, PART}; run_gemm(lds, ACT, DFF, wdn0 + (size_t)D * DFF, M, D, DFF, E); }
        else { pg8::EpiResid<false, true> E{H, H, modl + 8 * D, nullptr, nullptr, nullptr}; run_gemm(lds, ACT, DFF, wdn0 + (size_t)D * DFF, M, D, DFF, E); }
        GSYNC();

#undef GSYNC
}
__global__ void __launch_bounds__(NTHREADS, 2) mega_fwd(Args a) {
    extern __shared__ __attribute__((aligned(16))) unsigned char lds[];
    cg::grid_group grid = cg::this_grid();
    const int tid = threadIdx.x;
    unsigned char* ws = a.ws;
    const float* MOD = (const float*)(ws + WS_MOD);
    bf16* U = (bf16*)(ws + WS_U);
    bf16* ACT = (bf16*)(ws + WS_ACT);
    float* H = a.out;

    if (tid < 2) ((volatile LAS unsigned*)((LAS unsigned char*)lds + XB_LDS_OFF))[tid] = 0u;
    __syncthreads();
    for (int rep = 0; rep < REP_P0; ++rep) { p0_prep(a, lds, tid); grid.sync(); }
    const XcdBarrier bar = xcd_barrier_post((unsigned*)(ws + WS_BAR), (volatile LAS unsigned*)((LAS unsigned char*)lds + XB_LDS_OFF));
#define GSYNC() xcd_barrier(bar)

    float* PART = (float*)(ws + WS_PART); const float* BV = (const float*)(ws + WS_BIAS);
    for (int rep = 0; rep < REP_NORM; ++rep) { norm_phase(a.in[I_X], MOD, 0, U, 0, tid); bias_phase(ws, tid); GSYNC(); }
    layer_body<0>(a, lds, bar, tid);
    layer_body<1>(a, lds, bar, tid);
}

extern "C" void kernel_launch(void* const* d_in, const int* in_sizes, int n_in, void* d_out, int out_size, void* d_ws, size_t ws_size, hipStream_t stream) {
    static int grid = 0;
    if (grid == 0) {
        if (n_in != 27 || out_size != M * D || ws_size < WS_NEED) { fprintf(stderr, "kernel_launch: unexpected shapes (n_in %d out %d ws %zu)\n", n_in, out_size, ws_size); grid = -1; return; }
        int dev = 0, cus = 0, per_cu = 0;
        hipGetDevice(&dev);
        hipDeviceGetAttribute(&cus, hipDeviceAttributeMultiprocessorCount, dev);
        hipFuncSetAttribute((const void*)mega_fwd, hipFuncAttributeMaxDynamicSharedMemorySize, LDS_BYTES);
        hipOccupancyMaxActiveBlocksPerMultiprocessor(&per_cu, (const void*)mega_fwd, NTHREADS, LDS_BYTES);
        if (per_cu < 1) per_cu = 1;
        grid = cus * per_cu;
        (void)hipGetLastError();
    }
    if (grid < 0) return;
    Args a{};
    for (int i = 0; i < 27; ++i) a.in[i] = (const float*)d_in[i];
    a.out = (float*)d_out; a.ws = (unsigned char*)d_ws;
    void* args[] = {&a};
    hipError_t e = hipLaunchCooperativeKernel((void*)mega_fwd, dim3(grid), dim3(NTHREADS), args, LDS_BYTES, stream);
    if (e != hipSuccess) fprintf(stderr, "cooperative launch failed: %s (grid %d)\n", hipGetErrorString(e), grid);
}
```

```cpp
#include <hip/hip_runtime.h>
#include <hip/hip_cooperative_groups.h>
#include <cstdio>
#include <cstdint>
namespace cg = cooperative_groups;
namespace pg8 {
#define PG8_LAS __attribute__((address_space(3)))
typedef unsigned short bf16_t;
typedef short bf16x8 __attribute__((ext_vector_type(8)));
typedef float f32x4 __attribute__((ext_vector_type(4)));
typedef unsigned u32x4 __attribute__((ext_vector_type(4)));
constexpr int BM = 256, BK = 64, HALF = 128, HTB = HALF * BK * 2  , STAGE_BYTES = 8 * HTB, NXCD = 8, WGM = 8;

__host__ __device__ __forceinline__ int lds_byte(int r, int c) { const int st = (r >> 4) * 2 + (c >> 5), rr = r & 15, cc = c & 31, ob = rr * 64 + cc * 2; return st * 1024 + (ob ^ (((ob >> 9) & 1) << 5)); }
__host__ __device__ __forceinline__ void stage_rc(int b, int& R, int& C) { const int st = b / 1024, sb = b % 1024, swz = sb ^ (((sb >> 9) & 1) << 5); R = (st >> 1) * 16 + swz / 64; C = (st & 1) * 32 + (swz % 64) / 2; }
__host__ __device__ __forceinline__ int perm32(int rho) { const int n = rho >> 4, i = rho & 15; return 8 * (i >> 2) + 4 * n + (i & 3); }

struct Unit { int pm, pn; };
struct Gemm { const bf16_t* A; const bf16_t* Bt; int M, N, K, lda; };

struct StaticOrder {
    int nM, nN, nwg, G, c;
    __host__ __device__ void init(int M, int N, int G_, int c_) { nM = M / BM; nN = N / BM; nwg = nM * nN; G = G_; c = c_; }
    __host__ __device__ bool next(int i, Unit& u) const {
        const long L = (long)i * G + c; if (L >= nwg) return false;
        int wgid = (int)L; { const int q = nwg / NXCD, r = nwg % NXCD, xcd = wgid % NXCD, off = wgid / NXCD; wgid = (xcd < r ? xcd * (q + 1) : r * (q + 1) + (xcd - r) * q) + off; }
        const int nig = WGM * nN, gid = wgid / nig, fm = gid * WGM, gsz = (nM - fm) < WGM ? (nM - fm) : WGM;
        u.pm = fm + ((wgid % nig) % gsz); u.pn = (wgid % nig) / gsz; return true;
    }
    __device__ __forceinline__ void a_ready(const Unit&) const {}
    __device__ __forceinline__ void done(const Unit&) const {}
};

__device__ __forceinline__ unsigned cvt_pk_bf16(float lo, float hi) { unsigned r; asm volatile("v_cvt_pk_bf16_f32 %0, %1, %2" : "=v"(r) : "v"(lo), "v"(hi)); return r; }
template <class Epi, class Sched, bool ALIGN_EPI = false, bool SP2 = false>
__device__ __forceinline__ void gemm_phase(PG8_LAS unsigned char* lds, const Gemm g, const Sched& S, const Epi& E) {
    int tid_ = threadIdx.x; asm volatile("" : "+v"(tid_));
    const int tid = tid_, wid = __builtin_amdgcn_readfirstlane(tid >> 6), lane = tid & 63, wr = wid >> 2, wc = wid & 3, fr = lane & 15, fq = lane >> 4;
    const int K = g.K, nt = K / BK;
    unsigned voffA[2], voffB[2];
#pragma unroll
    for (int i = 0; i < 2; ++i) { int R, C; stage_rc(tid * 16 + i * 8192, R, C); const int Rb = Epi::PERM ? ((R & ~31) + perm32(R & 31)) : R;
        voffA[i] = (unsigned)(R * g.lda + C) * 2u; voffB[i] = (unsigned)(Rb * K + C) * 2u; }
    const size_t kstep = (size_t)(BK * 2);
    const size_t hstepA = (size_t)HALF * g.lda * 2, hstepB = (size_t)HALF * K * 2;
    const size_t tstepA = 2 * hstepA, tstepB = 2 * hstepB;
    const unsigned ldsw = (unsigned)wid * 1024u;
    const int aoff = lds_byte(wr * 64 + fr, fq * 8), boff = lds_byte(wc * 32 + fr, fq * 8);
#define PG8_SA(b, h) (((b) * 2 + (h)) * HTB)
#define PG8_SB(b, h) ((4 + (b) * 2 + (h)) * HTB)
#define PG8_STAGE(bufoff, gbase, voff) do { _Pragma("unroll") for (int _i = 0; _i < 2; ++_i) \
        __builtin_amdgcn_global_load_lds((const unsigned*)((const char*)(gbase) + (voff)[_i]), (PG8_LAS unsigned*)(lds + (bufoff) + ldsw + _i * 8192), 16, 0, 0); } while (0)
#define PG8_LDA(dst, b, h) do { _Pragma("unroll") for (int m = 0; m < 4; ++m) _Pragma("unroll") for (int k = 0; k < 2; ++k) dst[m][k] = *(const PG8_LAS bf16x8*)(lds + PG8_SA(b, h) + aoff + m * 2048 + k * 1024); } while (0)
#define PG8_LDB(dst, b, h) do { _Pragma("unroll") for (int n = 0; n < 2; ++n) _Pragma("unroll") for (int k = 0; k < 2; ++k) dst[n][k] = *(const PG8_LAS bf16x8*)(lds + PG8_SB(b, h) + boff + n * 2048 + k * 1024); } while (0)
#define PG8_MMA(ai, bj, At, Bt) do { __builtin_amdgcn_s_setprio(1); _Pragma("unroll") for (int m = 0; m < 4; ++m) _Pragma("unroll") for (int n = 0; n < 2; ++n) _Pragma("unroll") for (int k = 0; k < 2; ++k) \
        acc[ai][bj][m][n] = __builtin_amdgcn_mfma_f32_16x16x32_bf16(Bt[n][k], At[m][k], acc[ai][bj][m][n], 0, 0, 0); __builtin_amdgcn_s_setprio(0); } while (0)
#define PG8_WAIT_V(n) asm volatile("s_waitcnt vmcnt(" #n ")" ::: "memory")
#define PG8_WAIT_L(n) asm volatile("s_waitcnt lgkmcnt(" #n ")" ::: "memory")
#define PG8_BAR __builtin_amdgcn_s_barrier()
#define PG8_SCHED __builtin_amdgcn_sched_barrier(0)
    Unit cur, nxt; int ui = 0;
    if (!S.next(0, cur)) return;
    f32x4 acc[2][2][4][2];
#pragma unroll
    for (int a = 0; a < 2; ++a)
#pragma unroll
        for (int b = 0; b < 2; ++b)
#pragma unroll
            for (int m = 0; m < 4; ++m)
#pragma unroll
                for (int n = 0; n < 2; ++n) acc[a][b][m][n] = (f32x4){0.f, 0.f, 0.f, 0.f};
    bf16x8 At[4][2], B0[2][2], B1[2][2];
    const char* cA = (const char*)g.A + (size_t)cur.pm * tstepA; const char* cB = (const char*)g.Bt + (size_t)cur.pn * tstepB;
    S.a_ready(cur);
    if constexpr (SP2) {
        PG8_STAGE(PG8_SB(0, 0), cB, voffB); PG8_STAGE(PG8_SB(0, 1), cB + hstepB, voffB); PG8_STAGE(PG8_SA(0, 0), cA, voffA); PG8_STAGE(PG8_SA(0, 1), cA + hstepA, voffA);
        if (wr == 1) PG8_BAR;
        PG8_WAIT_V(2); PG8_BAR;
        PG8_STAGE(PG8_SB(1, 0), cB + kstep, voffB); PG8_STAGE(PG8_SA(1, 0), cA + kstep, voffA); PG8_STAGE(PG8_SB(1, 1), cB + hstepB + kstep, voffB);
        PG8_WAIT_V(6); PG8_BAR;
    } else {
        PG8_STAGE(PG8_SB(0, 0), cB, voffB); PG8_STAGE(PG8_SA(0, 0), cA, voffA); PG8_STAGE(PG8_SB(0, 1), cB + hstepB, voffB); PG8_STAGE(PG8_SA(0, 1), cA + hstepA, voffA);
        if (wr == 1) PG8_BAR;
        PG8_WAIT_V(4); PG8_BAR;
        PG8_STAGE(PG8_SB(1, 0), cB + kstep, voffB); PG8_STAGE(PG8_SA(1, 0), cA + kstep, voffA); PG8_STAGE(PG8_SB(1, 1), cB + hstepB + kstep, voffB);
        PG8_WAIT_V(6); PG8_BAR;
    }
    for (;;) {
        const bool has_next = S.next(ui + 1, nxt);
        const char* nA = has_next ? (const char*)g.A + (size_t)nxt.pm * tstepA : cA; const char* nB = has_next ? (const char*)g.Bt + (size_t)nxt.pn * tstepB : cB;
        for (int t = 0; t < nt; t += 2) {
            const bool last = (t == nt - 2);
            const char* a1 = cA + (size_t)(t + 1) * kstep;
            const char* a2 = last ? nA : cA + (size_t)(t + 2) * kstep; const char* b2 = last ? nB : cB + (size_t)(t + 2) * kstep;
            const char* a3 = a2 + kstep; const char* b3 = b2 + kstep;
            if (last && has_next) S.a_ready(nxt);
            if constexpr (SP2) {
            PG8_LDB(B0, 0, 0); PG8_LDB(B1, 0, 1); PG8_SCHED; PG8_LDA(At, 0, 0); PG8_STAGE(PG8_SA(1, 1), a1 + hstepA, voffA);
            PG8_WAIT_V(8); PG8_WAIT_L(0); PG8_BAR; PG8_MMA(0, 0, At, B0); PG8_MMA(0, 1, At, B1); PG8_BAR; PG8_SCHED;
            PG8_LDA(At, 0, 1); PG8_STAGE(PG8_SB(0, 0), b2, voffB); PG8_STAGE(PG8_SB(0, 1), b2 + hstepB, voffB); PG8_STAGE(PG8_SA(0, 0), a2, voffA);
            PG8_WAIT_V(8); PG8_WAIT_L(0); PG8_BAR; PG8_MMA(1, 0, At, B0); PG8_MMA(1, 1, At, B1); PG8_BAR; PG8_SCHED;
            PG8_LDB(B0, 1, 0); PG8_LDB(B1, 1, 1); PG8_SCHED; PG8_LDA(At, 1, 0); PG8_STAGE(PG8_SA(0, 1), a2 + hstepA, voffA);
            PG8_WAIT_V(8); PG8_WAIT_L(0); PG8_BAR; PG8_MMA(0, 0, At, B0); PG8_MMA(0, 1, At, B1); PG8_BAR; PG8_SCHED;
            PG8_LDA(At, 1, 1); PG8_STAGE(PG8_SB(1, 0), b3, voffB); PG8_STAGE(PG8_SB(1, 1), b3 + hstepB, voffB); PG8_STAGE(PG8_SA(1, 0), a3, voffA);
            PG8_WAIT_V(8); PG8_WAIT_L(0); PG8_BAR; PG8_MMA(1, 0, At, B0); PG8_MMA(1, 1, At, B1); PG8_BAR; PG8_SCHED;
            } else {
            PG8_LDB(B0, 0, 0); PG8_SCHED; PG8_LDA(At, 0, 0); PG8_STAGE(PG8_SA(1, 1), a1 + hstepA, voffA);
            PG8_WAIT_L(8); PG8_BAR; PG8_WAIT_L(0); PG8_MMA(0, 0, At, B0); PG8_BAR; PG8_SCHED;
            PG8_LDB(B1, 0, 1); PG8_STAGE(PG8_SB(0, 0), b2, voffB);
            PG8_BAR; PG8_WAIT_L(0); PG8_MMA(0, 1, At, B1); PG8_BAR;
            PG8_LDA(At, 0, 1); PG8_STAGE(PG8_SA(0, 0), a2, voffA);
            PG8_BAR; PG8_WAIT_L(0); PG8_MMA(1, 0, At, B0); PG8_BAR; PG8_SCHED;
            PG8_STAGE(PG8_SB(0, 1), b2 + hstepB, voffB);
            PG8_WAIT_V(6); PG8_BAR; PG8_MMA(1, 1, At, B1); PG8_BAR;
            PG8_LDB(B0, 1, 0); PG8_SCHED; PG8_LDA(At, 1, 0); PG8_STAGE(PG8_SA(0, 1), a2 + hstepA, voffA);
            PG8_WAIT_L(8); PG8_BAR; PG8_WAIT_L(0); PG8_MMA(0, 0, At, B0); PG8_BAR; PG8_SCHED;
            PG8_LDB(B1, 1, 1); PG8_STAGE(PG8_SB(1, 0), b3, voffB);
            PG8_BAR; PG8_WAIT_L(0); PG8_MMA(0, 1, At, B1); PG8_BAR;
            PG8_LDA(At, 1, 1); PG8_STAGE(PG8_SA(1, 0), a3, voffA);
            PG8_BAR; PG8_WAIT_L(0); PG8_MMA(1, 0, At, B0); PG8_BAR; PG8_SCHED;
            PG8_STAGE(PG8_SB(1, 1), b3 + hstepB, voffB);
            PG8_WAIT_V(6); PG8_BAR; PG8_MMA(1, 1, At, B1); PG8_BAR;
            }
        }
        if constexpr (ALIGN_EPI) { if (wr == 0) PG8_BAR; }
        if constexpr (!Epi::AFTER_DRAIN) { E(acc, cur, wr, wc, fr, fq); S.done(cur); }
        if (!has_next) break;
#pragma unroll
        for (int a = 0; a < 2; ++a)
#pragma unroll
            for (int b = 0; b < 2; ++b)
#pragma unroll
                for (int m = 0; m < 4; ++m)
#pragma unroll
                    for (int n = 0; n < 2; ++n) acc[a][b][m][n] = (f32x4){0.f, 0.f, 0.f, 0.f};
        cur = nxt; cA = nA; cB = nB; ++ui;
        if constexpr (ALIGN_EPI) { if (wr == 1) PG8_BAR; }
    }
    PG8_WAIT_V(0);
    if constexpr (!ALIGN_EPI) { if (wr == 0) PG8_BAR; }
    PG8_BAR;
    if constexpr (Epi::AFTER_DRAIN) { E.fused(acc, cur, wr, wc, fr, fq, lds, wid, lane); S.done(cur); }
#undef PG8_SA
#undef PG8_SB
#undef PG8_STAGE
#undef PG8_LDA
#undef PG8_LDB
#undef PG8_MMA
#undef PG8_WAIT_V
#undef PG8_WAIT_L
#undef PG8_BAR
#undef PG8_SCHED
}
}
#ifndef REP_INDEX
#define REP_INDEX 1
#endif
#ifndef REP_ATTN
#define REP_ATTN 1
#endif
#ifndef REP_DPREP
#define REP_DPREP 1
#endif
#ifndef REP_SCAN
#define REP_SCAN 1
#endif
#ifndef REP_RWIN
#define REP_RWIN 1
#endif
#define LAS __attribute__((address_space(3)))
typedef unsigned short bf16;
typedef float f32x4 __attribute__((ext_vector_type(4)));
typedef float f32x2 __attribute__((ext_vector_type(2)));
typedef float f32x16 __attribute__((ext_vector_type(16)));
typedef short bf16x8 __attribute__((ext_vector_type(8)));
typedef unsigned u32x4 __attribute__((ext_vector_type(4)));
typedef unsigned u32x2 __attribute__((ext_vector_type(2)));
typedef unsigned long long u64;

constexpr int D = 1024, NB = 8, SEQ = 4096, M = NB * SEQ, DFF = 2816, NMOD = 9 * D;
constexpr int DSA_N = 2304, DSA_NREAL = 2120;
constexpr int RW_N = 3584, RW_K = 2048, LORA_K = 384;
constexpr int LDS_BYTES = 147456;
constexpr int NTHREADS = 512;
constexpr size_t MiB = 1u << 20;
constexpr size_t WS_MOD = 0;
constexpr size_t WS_BAR = 768 * 1024;
constexpr int XB_LDS_OFF = 140000;
constexpr size_t WS_L1W = 1 * MiB;
constexpr size_t WS_WGU1 = WS_L1W;
constexpr size_t WS_WDN1 = WS_WGU1 + 22 * MiB;
constexpr size_t WS_WRWIN = WS_WDN1 + 11 * MiB;
constexpr size_t WS_WLORA = WS_WRWIN + 14 * MiB;
constexpr size_t WS_WRWOUT = WS_WLORA + 3 * MiB;
constexpr size_t WS_L0W = 53 * MiB;
constexpr size_t WS_WGU0 = WS_L0W;
constexpr size_t WS_WDN0 = WS_WGU0 + 22 * MiB;
constexpr size_t WS_WDSAIN = WS_WDN0 + 11 * MiB;
constexpr size_t WS_WDSAOUT = WS_WDSAIN + 5 * MiB;
constexpr size_t WS_U = 93 * MiB;
constexpr size_t WS_ACT = 157 * MiB;
constexpr size_t WS_QKVI = 157 * MiB;
constexpr size_t WS_QN = 301 * MiB;
constexpr size_t WS_KN = 365 * MiB;
constexpr size_t WS_VT = 381 * MiB;
constexpr size_t WS_IKN = 397 * MiB;
constexpr size_t WS_IW = 401 * MiB;
constexpr size_t WS_MASK = 402 * MiB;
constexpr size_t WS_A2 = 53 * MiB;
constexpr size_t WS_RK = 181 * MiB;
constexpr size_t WS_Y = 405 * MiB;
constexpr size_t WS_BIAS = 470 * MiB;
constexpr size_t WS_PART = 471 * MiB;
constexpr size_t WS_NEED = 473 * MiB;
constexpr int BV_GU0B = 0, BV_DSA = 8 * 5632, BV_GU1A = BV_DSA + 8 * 2304, BV_GU1B = BV_GU1A + 8 * 5632;

struct Args {
    const float* in[27];
    float* out; unsigned char* ws;
};
enum { I_X = 0, I_C, I_ADAW, I_ADAB, I_WGU, I_WDN, I_DSAIN, I_QNORM, I_KNORM, I_IKNORM, I_DSAOUT, I_MU, I_WRKV, I_W0, I_W1, I_W2, I_A0, I_A1, I_A2,
       I_G1, I_G2, I_KK, I_KA, I_RK, I_LNW, I_LNB, I_RWOUT };

__device__ __forceinline__ unsigned f2bf(float f) { unsigned u = __builtin_bit_cast(unsigned, f); return (u + 0x7fffu + ((u >> 16) & 1u)) >> 16; }
typedef __bf16 hwbf16x2 __attribute__((ext_vector_type(2)));
__device__ __forceinline__ unsigned pk2(float lo, float hi) { const f32x2 v = {lo, hi}; const hwbf16x2 b = __builtin_convertvector(v, hwbf16x2); return __builtin_bit_cast(unsigned, b); }
__device__ __forceinline__ float bf2f(unsigned short b) { return __builtin_bit_cast(float, (unsigned)b << 16); }
__device__ __forceinline__ float bflo(unsigned w) { return __builtin_bit_cast(float, w << 16); }
__device__ __forceinline__ float bfhi(unsigned w) { return __builtin_bit_cast(float, w & 0xffff0000u); }
__device__ __forceinline__ float wave_sum(float v) {
#pragma unroll
    for (int o = 1; o < 64; o <<= 1) v += __shfl_xor(v, o);
    return v;
}
template <int CTRL> __device__ __forceinline__ float dppf(float v) { return __builtin_bit_cast(float, __builtin_amdgcn_mov_dpp(__builtin_bit_cast(int, v), CTRL, 0xF, 0xF, true)); }
__device__ __forceinline__ float row16_sum(float v) {
    v += dppf<0xB1>(v);
    v += dppf<0x4E>(v);
    v += dppf<0x141>(v);
    v += dppf<0x140>(v);
    return v;
}
__device__ __forceinline__ float sigmoidf_(float x) { return __builtin_amdgcn_rcpf(1.f + __expf(-x)); }
__device__ __forceinline__ float siluf_(float x) { return x * sigmoidf_(x); }

struct XDesc { const float* W; int K, N, Npad; bf16* WT; int ldo, koff, rowoff, mode; const float* kscale; };
__device__ __forceinline__ void xpose_load(const XDesc& d, int tile, int tid, float (&v)[8]) {
    const int ntn = d.Npad / 64, kb = tile / ntn, nb = tile % ntn, k0 = kb * 64, n0 = nb * 64;
    const int nn = tid & 63, n = n0 + nn;
#pragma unroll
    for (int i = 0; i < 8; ++i) {
        const int kk = (tid >> 6) + 8 * i, k = k0 + kk;
        float x = (n < d.N) ? d.W[(size_t)k * d.N + n] : 0.f;
        if (d.kscale) x *= d.kscale[k];
        v[i] = x;
    }
}
__device__ __forceinline__ void xpose_lds(const float (&v)[8], float* scr, int tid) {
#pragma unroll
    for (int i = 0; i < 8; ++i) scr[((tid >> 6) + 8 * i) * 65 + (tid & 63)] = v[i];
}
__device__ __forceinline__ void xpose_write(const XDesc& d, int tile, const float* scr, int tid) {
    const int ntn = d.Npad / 64, kb = tile / ntn, nb = tile % ntn, k0 = kb * 64, n0 = nb * 64;
    const int nl = tid >> 3, kc = (tid & 7) * 8, n = n0 + nl;
    const int orow = d.rowoff + (d.mode == 1 ? ((n % DFF) * 2 + n / DFF) : n);
    const float* s = scr + kc * 65 + nl;
    u32x4 o; o.x = pk2(s[0], s[65]); o.y = pk2(s[2 * 65], s[3 * 65]); o.z = pk2(s[4 * 65], s[5 * 65]); o.w = pk2(s[6 * 65], s[7 * 65]);
    *(u32x4*)(d.WT + (size_t)orow * d.ldo + d.koff + k0 + kc) = o;
}
__device__ __forceinline__ int xd_tiles(int K, int Npad) { return (K / 64) * (Npad / 64); }

#define P0_DECODE(it_, d, r) do { r = (it_); d.mode = 0; d.kscale = nullptr; d.koff = 0; d.rowoff = 0;\
        if (r < 4 * T_GU) { const int w = r / T_GU; r -= w * T_GU; \
            d.W = a.in[I_WGU] + (size_t)w * D * 2 * DFF; d.K = D; d.N = 2 * DFF; d.Npad = 2 * DFF; d.ldo = D; d.mode = 1;\
            d.WT = (bf16*)(ws + (w < 2 ? WS_WGU0 + (size_t)w * 11 * MiB : WS_WGU1 + (size_t)(w - 2) * 11 * MiB));\
        } else if ((r -= 4 * T_GU) < 4 * T_DN) { const int w = r / T_DN; r -= w * T_DN;\
            d.W = a.in[I_WDN] + (size_t)w * DFF * D; d.K = DFF; d.N = D; d.Npad = D; d.ldo = DFF;\
            d.WT = (bf16*)(ws + (w < 2 ? WS_WDN0 + (size_t)w * 5767168 : WS_WDN1 + (size_t)(w - 2) * 5767168));\
        } else if ((r -= 4 * T_DN) < T_DIN) {\
            d.W = a.in[I_DSAIN]; d.K = D; d.N = DSA_NREAL; d.Npad = DSA_N; d.ldo = D; d.WT = (bf16*)(ws + WS_WDSAIN);\
        } else if ((r -= T_DIN) < T_SQ) {\
            d.W = a.in[I_DSAOUT]; d.K = D; d.N = D; d.Npad = D; d.ldo = D; d.WT = (bf16*)(ws + WS_WDSAOUT);\
        } else if ((r -= T_SQ) < 6 * T_SQ) { const int w = r / T_SQ; r -= w * T_SQ; const int i = w >> 1, sec = w & 1; \
            d.W = a.in[I_WRKV] + (size_t)i * D * D; d.K = D; d.N = D; d.Npad = D; d.ldo = RW_K; d.koff = sec * D; d.rowoff = i * D;\
            d.kscale = sec ? a.in[I_MU] + i * D : nullptr; d.WT = (bf16*)(ws + WS_WRWIN);\
        } else if ((r -= 6 * T_SQ) < 4 * T_L64) { const int w = r / T_L64; r -= w * T_L64; const int i = w >> 1, sec = w & 1; \
            d.W = a.in[i == 0 ? I_W1 : I_A1]; d.K = D; d.N = 64; d.Npad = 64; d.ldo = RW_K; d.koff = sec * D; d.rowoff = 3072 + 64 * i;\
            d.kscale = sec ? a.in[I_MU] + (3 + i) * D : nullptr; d.WT = (bf16*)(ws + WS_WRWIN);\
        } else if ((r -= 4 * T_L64) < 2 * T_G1) { const int sec = r / T_G1; r -= sec * T_G1;\
            d.W = a.in[I_G1]; d.K = D; d.N = 160; d.Npad = 384; d.ldo = RW_K; d.koff = sec * D; d.rowoff = 3200;\
            d.kscale = sec ? a.in[I_MU] + 5 * D : nullptr; d.WT = (bf16*)(ws + WS_WRWIN);\
        } else { r -= 2 * T_G1;\
            d.W = a.in[I_RWOUT]; d.K = D; d.N = D; d.Npad = D; d.ldo = D; d.WT = (bf16*)(ws + WS_WRWOUT);\
        } } while (0)
__device__ __forceinline__ void p0_prep(const Args& a, unsigned char* lds, int tid) {
    asm volatile("" : "+v"(tid));
    unsigned char* ws = a.ws;
    float* scr = (float*)lds;
    float* cs = (float*)(lds + 16640);
    float* red = (float*)(lds + 16640 + 32768);
    const int G = gridDim.x, bid = blockIdx.x;
    if (bid == 0) { unsigned* bw = (unsigned*)(ws + WS_BAR); for (int i = tid; i < 3456; i += NTHREADS) bw[i] = 0u; }
    constexpr int T_GU = 16 * 88, T_DN = 44 * 16, T_DIN = 16 * 36, T_SQ = 16 * 16, T_L64 = 16 * 1, T_G1 = 16 * 6;
    constexpr int NDESC = 4 + 4 + 1 + 1 + 6 + 2 + 2 + 2 + 1;
    int total = 4 * T_GU + 4 * T_DN + T_DIN + T_SQ + 6 * T_SQ + 4 * T_L64 + 2 * T_G1 + T_SQ;
    {
        XDesc d, dn; int r = 0, rn = 0; float v[8], vn[8];
        int it = bid;
        if (it < total) { P0_DECODE(it, d, r); xpose_load(d, r, tid, v); }
        while (it < total) {
            xpose_lds(v, scr, tid);
            __syncthreads();
            const int itn = it + G;
            if (itn < total) { P0_DECODE(itn, dn, rn); xpose_load(dn, rn, tid, vn); }
            xpose_write(d, r, scr, tid);
            __syncthreads();
            d = dn; r = rn; it = itn;
#pragma unroll
            for (int i = 0; i < 8; ++i) v[i] = vn[i];
        }
    }
    (void)NDESC;
    {
        bf16* WL = (bf16*)(ws + WS_WLORA);
        for (int idx = bid * NTHREADS + tid; idx < (LORA_K / 8) * 3072; idx += G * NTHREADS) {
            const int kg = idx / 3072, n = idx % 3072, blk = n >> 10, nn = n & 1023;
            float v[8];
#pragma unroll
            for (int j = 0; j < 8; ++j) { const int k = kg * 8 + j; float x = 0.f;
                if (blk == 0) { if (k < 64) x = a.in[I_W2][(size_t)k * D + nn]; }
                else if (blk == 1) { if (k >= 64 && k < 128) x = a.in[I_A2][(size_t)(k - 64) * D + nn]; }
                else { if (k >= 128 && k < 288) x = a.in[I_G2][(size_t)(k - 128) * D + nn]; }
                v[j] = x; }
            u32x4 o; o.x = pk2(v[0], v[1]); o.y = pk2(v[2], v[3]); o.z = pk2(v[4], v[5]); o.w = pk2(v[6], v[7]);
            *(u32x4*)(WL + (size_t)n * LORA_K + kg * 8) = o;
        }
    }
    if (bid < 288) {
        for (int i = tid; i < NB * D; i += NTHREADS) cs[i] = siluf_(a.in[I_C][i]);
        __syncthreads();
        const int lane = tid & 63, w = tid >> 6;
        float* MOD = (float*)(ws + WS_MOD);
        for (int tile = bid; tile < 288; tile += G) {
            const int l = tile / 144, n = (tile % 144) * 64 + lane;
            const float* wp = a.in[I_ADAW] + ((size_t)l * D + w * 128) * NMOD + n;
            float acc[8];
#pragma unroll
            for (int b = 0; b < 8; ++b) acc[b] = 0.f;
#pragma unroll 32
            for (int k = 0; k < 128; ++k) { const float wv = wp[(size_t)k * NMOD];
#pragma unroll
                for (int b = 0; b < 8; ++b) acc[b] += cs[b * D + w * 128 + k] * wv; }
#pragma unroll
            for (int b = 0; b < 8; ++b) red[(w * 8 + b) * 64 + lane] = acc[b];
            __syncthreads();
            { const int b = tid >> 6; float s = a.in[I_ADAB][l * NMOD + n];
#pragma unroll
              for (int ww = 0; ww < 8; ++ww) s += red[(ww * 8 + b) * 64 + lane];
              MOD[(size_t)(l * 8 + b) * NMOD + n] = s; }
            __syncthreads();
        }
    }
}

__device__ __forceinline__ void norm_row(const float* hrow, const float* sh, const float* sc, int lane, f32x4 (&u)[4]) {
    float ss = 0.f;
#pragma unroll
    for (int j = 0; j < 4; ++j) { u[j] = *(const f32x4*)(hrow + 4 * lane + 256 * j); ss += (u[j].x * u[j].x + u[j].y * u[j].y) + (u[j].z * u[j].z + u[j].w * u[j].w); }
    ss = wave_sum(ss);
    const float rstd = __builtin_amdgcn_rsqf(ss * (1.f / D) + 1e-6f);
#pragma unroll
    for (int j = 0; j < 4; ++j) { const f32x4 a = *(const f32x4*)(sc + 4 * lane + 256 * j), b = *(const f32x4*)(sh + 4 * lane + 256 * j);
        u[j] = (u[j] * rstd) * (a + 1.0f) + b; }
}
__device__ __forceinline__ void norm_phase(const float* h, const float* modl  , int idx  , bf16* U, int mode, int tid) {
    asm volatile("" : "+v"(tid));
    const int lane = tid & 63, gw = blockIdx.x * 8 + (tid >> 6), NGW = gridDim.x * 8;
    for (int row = gw; row < M; row += NGW) {
        const int b = row >> 12, t = row & (SEQ - 1);
        const float* sh = modl + (size_t)b * NMOD + (idx * 3) * D; const float* sc = sh + D;
        f32x4 u[4]; norm_row(h + (size_t)row * D, sh, sc, lane, u);
        if (mode == 0) {
#pragma unroll
            for (int j = 0; j < 4; ++j) { u32x2 o; o.x = pk2(u[j].x, u[j].y); o.y = pk2(u[j].z, u[j].w); *(u32x2*)(U + (size_t)row * D + 4 * lane + 256 * j) = o; }
        } else {
            f32x4 p[4];
            if (t > 0) norm_row(h + (size_t)(row - 1) * D, sh, sc, lane, p);
            else {
#pragma unroll
                for (int j = 0; j < 4; ++j) p[j] = (f32x4){0.f, 0.f, 0.f, 0.f};
            }
#pragma unroll
            for (int j = 0; j < 4; ++j) { u32x2 o; o.x = pk2(u[j].x, u[j].y); o.y = pk2(u[j].z, u[j].w); *(u32x2*)(U + (size_t)row * RW_K + 4 * lane + 256 * j) = o;
                const f32x4 x = p[j] - u[j]; u32x2 q; q.x = pk2(x.x, x.y); q.y = pk2(x.z, x.w); *(u32x2*)(U + (size_t)row * RW_K + D + 4 * lane + 256 * j) = q; }
        }
    }
}

__device__ __forceinline__ void bias_phase(unsigned char* ws, int tid) {
    asm volatile("" : "+v"(tid));
    const int lane = tid & 63, gw = blockIdx.x * 8 + (tid >> 6), NGW = gridDim.x * 8;
    const int r16 = lane & 15, kg = lane >> 4;
    const float* MOD = (const float*)(ws + WS_MOD); float* BV = (float*)(ws + WS_BIAS);
    for (int task = gw; task < 352 * 3 + 144; task += NGW) {
        int t = task; const bf16* Bt; const float* sh; float* dst; int N;
        if (t < 352) { Bt = (const bf16*)(ws + WS_WGU0 + 11 * MiB); sh = MOD + 6 * D; dst = BV + BV_GU0B; N = 5632; }
        else if ((t -= 352) < 144) { Bt = (const bf16*)(ws + WS_WDSAIN); sh = MOD + 3 * D; dst = BV + BV_DSA; N = 2304; }
        else if ((t -= 144) < 352) { Bt = (const bf16*)(ws + WS_WGU1); sh = MOD + (size_t)8 * NMOD; dst = BV + BV_GU1A; N = 5632; }
        else { t -= 352; Bt = (const bf16*)(ws + WS_WGU1 + 11 * MiB); sh = MOD + (size_t)8 * NMOD + 6 * D; dst = BV + BV_GU1B; N = 5632; }
        const int n0 = t * 16;
        const float* ap = sh + (size_t)(r16 & 7) * NMOD + 8 * kg;
        const bf16* bp = Bt + (size_t)(n0 + r16) * D + 8 * kg;
        f32x4 acc = (f32x4){0.f, 0.f, 0.f, 0.f};
#pragma unroll 8
        for (int s = 0; s < 32; ++s) {
            const f32x4 x0 = *(const f32x4*)(ap + 32 * s), x1 = *(const f32x4*)(ap + 32 * s + 4);
            u32x4 aw; aw.x = pk2(x0.x, x0.y); aw.y = pk2(x0.z, x0.w); aw.z = pk2(x1.x, x1.y); aw.w = pk2(x1.z, x1.w);
            if (r16 >= 8) aw = (u32x4){0u, 0u, 0u, 0u};
            const bf16x8 bw = *(const bf16x8*)(bp + 32 * s);
            acc = __builtin_amdgcn_mfma_f32_16x16x32_bf16(__builtin_bit_cast(bf16x8, aw), bw, acc, 0, 0, 0);
        }
        if (kg < 2) {
#pragma unroll
            for (int v = 0; v < 4; ++v) dst[(size_t)(4 * kg + v) * N + n0 + r16] = acc[v];
        }
    }
}

namespace pg8 {
template <bool FOLD> struct EpiSwiglu {
    static constexpr bool PERM = true, AFTER_DRAIN = false;
    bf16_t* O; int ldc; const float* part; const float* biasv  ;
    __device__ __forceinline__ void operator()(const f32x4 (&acc)[2][2][4][2], const Unit& u, int wr, int wc, int fr, int fq) const {
        const int row0 = u.pm * BM + wr * 64 + fr, col0 = u.pn * BM + wc * 32 + 8 * fq;
        f32x4 bv[2][2];
        if (FOLD) { const float* bp = biasv + (size_t)(u.pm >> 4) * (2 * DFF) + col0;
#pragma unroll
            for (int bj = 0; bj < 2; ++bj) { bv[bj][0] = *(const f32x4*)(bp + bj * HALF); bv[bj][1] = *(const f32x4*)(bp + bj * HALF + 4); } }
        float rs[8];
        if (FOLD) {
#pragma unroll
            for (int i = 0; i < 8; ++i) { const f32x4 t = *(const f32x4*)(part + (size_t)(row0 + (i >> 2) * HALF + (i & 3) * 16) * 16 + 4 * fq); rs[i] = (t.x + t.y) + (t.z + t.w); }
#pragma unroll
            for (int i = 0; i < 8; ++i) { float t = rs[i]; t += __shfl_xor(t, 16); t += __shfl_xor(t, 32); rs[i] = __builtin_amdgcn_rsqf(t * (1.f / 1024.f) + 1e-6f); }
        }
#pragma unroll
        for (int ai = 0; ai < 2; ++ai)
#pragma unroll
            for (int m = 0; m < 4; ++m) { const int row = row0 + ai * HALF + m * 16; bf16_t* rowp = O + (size_t)row * ldc;
                const float rstd = FOLD ? rs[ai * 4 + m] : 1.f;
#pragma unroll
                for (int bj = 0; bj < 2; ++bj) { f32x4 v0 = acc[ai][bj][m][0], v1 = acc[ai][bj][m][1];
                    if (FOLD) { v0 = v0 * rstd + bv[bj][0]; v1 = v1 * rstd + bv[bj][1]; }
                    const float o0 = siluf_(v0[0]) * v0[1], o1 = siluf_(v0[2]) * v0[3], o2 = siluf_(v1[0]) * v1[1], o3 = siluf_(v1[2]) * v1[3];
                    u32x2 w; w.x = cvt_pk_bf16(o0, o1); w.y = cvt_pk_bf16(o2, o3);
                    *(u32x2*)(rowp + ((col0 + bj * HALF) >> 1)) = w; } }
    }
};
template <bool FOLD, bool HALFSC> struct EpiResid {
    static constexpr bool PERM = false, AFTER_DRAIN = false;
    const float* base; float* out; const float* gate  ;
    bf16_t* U2; const float* scn  ; float* part;
    __device__ __forceinline__ void operator()(const f32x4 (&acc)[2][2][4][2], const Unit& u, int wr, int wc, int fr, int fq) const {
        const int row0 = u.pm * BM + wr * 64 + fr, col0 = u.pn * BM + wc * 32 + 4 * fq;
        const float* gp = gate + (size_t)(u.pm >> 4) * NMOD;
        f32x4 gv[2][2], sv[2][2];
#pragma unroll
        for (int bj = 0; bj < 2; ++bj)
#pragma unroll
            for (int n = 0; n < 2; ++n) { gv[bj][n] = *(const f32x4*)(gp + col0 + bj * HALF + n * 16) * (HALFSC ? 0.5f : 1.0f);
                if (FOLD) sv[bj][n] = *(const f32x4*)(scn + (size_t)(u.pm >> 4) * NMOD + col0 + bj * HALF + n * 16) + 1.0f; }
#pragma unroll
        for (int ai = 0; ai < 2; ++ai)
#pragma unroll
            for (int m = 0; m < 4; ++m) { const int row = row0 + ai * HALF + m * 16; const size_t off = (size_t)row * D + col0;
                float ssq = 0.f;
#pragma unroll
                for (int bj = 0; bj < 2; ++bj)
#pragma unroll
                    for (int n = 0; n < 2; ++n) { const f32x4 bs = *(const f32x4*)(base + off + bj * HALF + n * 16);
                        const f32x4 o = bs + gv[bj][n] * acc[ai][bj][m][n];
                        *(f32x4*)(out + off + bj * HALF + n * 16) = o;
                        if (FOLD) { ssq += (o.x * o.x + o.y * o.y) + (o.z * o.z + o.w * o.w); const f32x4 q = o * sv[bj][n];
                            u32x2 w; w.x = cvt_pk_bf16(q.x, q.y); w.y = cvt_pk_bf16(q.z, q.w); *(u32x2*)(U2 + off + bj * HALF + n * 16) = w; } }
                if (FOLD) { ssq += __shfl_xor(ssq, 16); ssq += __shfl_xor(ssq, 32);
                    if (fq == 0) part[(size_t)row * 16 + (u.pn & 3) * 4 + wc] = ssq; } }
    }
};
template <int MODE> struct EpiBf16 {
    static constexpr bool PERM = true, AFTER_DRAIN = false;
    bf16_t* O; int ldc; const float* p0; const float* p1;
    __device__ __forceinline__ void operator()(const f32x4 (&acc)[2][2][4][2], const Unit& u, int wr, int wc, int fr, int fq) const {
        const int row0 = u.pm * BM + wr * 64 + fr, col0 = u.pn * BM + wc * 32 + 8 * fq;
        float rs[8];
        if (MODE == 3) {
#pragma unroll
            for (int i = 0; i < 8; ++i) { const f32x4 t = *(const f32x4*)(p0 + (size_t)(row0 + (i >> 2) * HALF + (i & 3) * 16) * 16 + 4 * fq); rs[i] = (t.x + t.y) + (t.z + t.w); }
#pragma unroll
            for (int i = 0; i < 8; ++i) { float t = rs[i]; t += __shfl_xor(t, 16); t += __shfl_xor(t, 32); rs[i] = __builtin_amdgcn_rsqf(t * (1.f / 1024.f) + 1e-6f); }
        }
#pragma unroll
        for (int bj = 0; bj < 2; ++bj) {
            const int c = col0 + bj * HALF;
            f32x4 b0 = (f32x4){0.f, 0.f, 0.f, 0.f}, b1 = b0; int kind = 0;
            if (MODE == 1) { kind = (c >= 3072 && c < 3136) ? 1 : ((c >= 3200) ? 2 : 0); }
            if (MODE == 3) { b0 = *(const f32x4*)(p1 + (size_t)(u.pm >> 4) * ldc + c); b1 = *(const f32x4*)(p1 + (size_t)(u.pm >> 4) * ldc + c + 4); }
            if (MODE == 2) { if (c < 1024) { kind = 3; b0 = *(const f32x4*)(p0 + c); b1 = *(const f32x4*)(p0 + c + 4); } else { kind = 2; b0 = *(const f32x4*)(p1 + c - 1024); b1 = *(const f32x4*)(p1 + c - 1024 + 4); } }
#pragma unroll
            for (int ai = 0; ai < 2; ++ai)
#pragma unroll
                for (int m = 0; m < 4; ++m) { bf16_t* rowp = O + (size_t)(row0 + ai * HALF + m * 16) * ldc + c;
                    f32x4 v0, v1;
                    if (MODE == 3) { const float rstd = rs[ai * 4 + m]; v0 = acc[ai][bj][m][0] * rstd + b0; v1 = acc[ai][bj][m][1] * rstd + b1; }
                    else { v0 = acc[ai][bj][m][0] + b0; v1 = acc[ai][bj][m][1] + b1; }
                    if (MODE == 1 || MODE == 2) {
#pragma unroll
                        for (int e = 0; e < 4; ++e) {
                            if (kind == 1) { v0[e] = 2.f * sigmoidf_(2.f * v0[e]) - 1.f; v1[e] = 2.f * sigmoidf_(2.f * v1[e]) - 1.f; }
                            else if (kind == 2) { v0[e] = sigmoidf_(v0[e]); v1[e] = sigmoidf_(v1[e]); }
                            else if (kind == 3) { v0[e] = 0.60653066f * sigmoidf_(v0[e]); v1[e] = 0.60653066f * sigmoidf_(v1[e]); }
                        }
                    }
                    u32x4 w; w.x = cvt_pk_bf16(v0[0], v0[1]); w.y = cvt_pk_bf16(v0[2], v0[3]); w.z = cvt_pk_bf16(v1[0], v1[1]); w.w = cvt_pk_bf16(v1[2], v1[3]);
                    *(u32x4*)rowp = w; }
        }
    }
};
}

template <bool ALIGN = true, class Epi> __device__ __forceinline__ void run_gemm(unsigned char* lds, const bf16* A, int lda, const bf16* Bt, int Mrows, int N, int K, const Epi& E) {
    asm volatile("" : "+s"(A), "+s"(Bt), "+s"(K));
    pg8::Gemm g{A, Bt, Mrows, N, K, lda}; pg8::StaticOrder S; S.init(Mrows, N, (int)gridDim.x, (int)blockIdx.x);
    pg8::gemm_phase<Epi, pg8::StaticOrder, ALIGN, true>((PG8_LAS unsigned char*)lds, g, S, E);
}
#define XB_TMO      128
#define XB_XCNT(j)  (256  + 64 * (j))
#define XB_XSUB(j)  (1280 + 64 * (j))
#define XB_XGEN(j)  (2304 + 64 * (j))
#define XB_TOP      3328
#define XB_TOPGEN   3392
#define XCD_BAR_WORDS 3456
#define XB_SPIN_CAP (1u << 18)

__device__ __forceinline__ unsigned xb_ld(unsigned* p)              { return __hip_atomic_load(p, __ATOMIC_RELAXED, __HIP_MEMORY_SCOPE_AGENT); }
__device__ __forceinline__ unsigned xb_add(unsigned* p, unsigned v) { return __hip_atomic_fetch_add(p, v, __ATOMIC_RELAXED, __HIP_MEMORY_SCOPE_AGENT); }
__device__ __forceinline__ unsigned xb_xcc_id() { return (unsigned)__builtin_amdgcn_s_getreg((3 << 11) | 20) & 0xFu; }
#define XB_SPIN(cond, bar) do { unsigned _sp = 0; while (cond) { __builtin_amdgcn_s_sleep(1); \
    if ((++_sp & 255u) == 0u) { if (xb_ld(&(bar)[XB_TMO])) break; if (_sp > XB_SPIN_CAP) { atomicAdd(&(bar)[XB_TMO], 1u); break; } } } } while (0)

struct XcdBarrier {
    unsigned* bar; unsigned x;
    volatile LAS unsigned* st;
};

__device__ __forceinline__ XcdBarrier xcd_barrier_post(unsigned* bar, volatile LAS unsigned* st) {
    XcdBarrier b; b.bar = bar; b.x = xb_xcc_id(); b.st = st;
    if (threadIdx.x == 0) (void)xb_add(&bar[XB_XCNT(b.x)], 1u);
    return b;
}
__device__ __forceinline__ void xcd_barrier_complete(unsigned* bar, unsigned x, unsigned& nloc, unsigned& nx) {
    const unsigned G = gridDim.x * gridDim.y * gridDim.z;
    unsigned sum, cnt, mine, sp = 0u;
    for (;;) {
        sum = 0u; cnt = 0u; mine = 0u;
#pragma unroll
        for (unsigned j = 0; j < 16; ++j) { const unsigned c = xb_ld(&bar[XB_XCNT(j)]); sum += c; cnt += (c > 0u) ? 1u : 0u; mine = (j == x) ? c : mine; }
        if (sum == G) break;
        __builtin_amdgcn_s_sleep(1);
        if ((++sp & 255u) == 0u) { if (xb_ld(&bar[XB_TMO])) break; if (sp > XB_SPIN_CAP) { atomicAdd(&bar[XB_TMO], 1u); break; } }
    }
    nloc = mine > 0u ? mine : 1u; nx = cnt > 0u ? cnt : 1u;
}

__device__ __forceinline__ void xcd_barrier(const XcdBarrier& b) {
    asm volatile("s_waitcnt vmcnt(0)" ::: "memory");
    __syncthreads();
    if (threadIdx.x == 0) {
        unsigned* bar = b.bar;
        __builtin_amdgcn_s_waitcnt(0);
        unsigned nloc = b.st[0], nx = b.st[1];
        if (nloc == 0u) { xcd_barrier_complete(bar, b.x, nloc, nx); b.st[0] = nloc; b.st[1] = nx; }
        const unsigned old = xb_add(&bar[XB_XSUB(b.x)], 1u);
        const unsigned gen = old / nloc;
        if (old + 1u == (gen + 1u) * nloc) {
            __builtin_amdgcn_fence(__ATOMIC_RELEASE, "agent");
            asm volatile("s_waitcnt vmcnt(0)" ::: "memory");
            const unsigned og = xb_add(&bar[XB_TOP], 1u);
            const unsigned tg = og / nx;
            if (og + 1u == (tg + 1u) * nx) xb_add(&bar[XB_TOPGEN], 1u);
            else XB_SPIN(xb_ld(&bar[XB_TOPGEN]) == tg, bar);
            __builtin_amdgcn_fence(__ATOMIC_ACQUIRE, "agent");
            xb_add(&bar[XB_XGEN(b.x)], 1u);
            asm volatile("s_waitcnt vmcnt(0)" ::: "memory");
        } else {
            XB_SPIN(xb_ld(&bar[XB_XGEN(b.x)]) == gen, bar);
            __builtin_amdgcn_fence(__ATOMIC_ACQUIRE, "agent");
            asm volatile("s_waitcnt vmcnt(0)" ::: "memory");
        }
    }
    __syncthreads();
}

constexpr int QKVI_LD = DSA_N;
constexpr float QSCALE = 0.18033688011112042f;
constexpr float IWSCALE = 0.04419417382415922f;

__device__ __forceinline__ void dsa_prep(const Args& a, unsigned char* lds, int tid) {
    asm volatile("" : "+v"(tid));
    unsigned char* ws = a.ws;
    const bf16* QKVI = (const bf16*)(ws + WS_QKVI);
    bf16* QN = (bf16*)(ws + WS_QN); bf16* KN = (bf16*)(ws + WS_KN); bf16* VT = (bf16*)(ws + WS_VT); bf16* IKN = (bf16*)(ws + WS_IKN); float* IW = (float*)(ws + WS_IW);
    bf16* vt = (bf16*)lds;
    const int lane = tid & 63, w = tid >> 6, sub = lane & 15, grp = lane >> 4;
    const f32x4 qn = *(const f32x4*)(a.in[I_QNORM] + 4 * sub), kn = *(const f32x4*)(a.in[I_KNORM] + 4 * sub), ikn = *(const f32x4*)(a.in[I_IKNORM] + 4 * sub);
    for (int blk = blockIdx.x; blk < M / 64; blk += gridDim.x) {
        const int t0 = blk * 64, b = t0 >> 12, tt0 = t0 & (SEQ - 1);
#pragma unroll 4
        for (int i = 0; i < 8; ++i) {
            const int row = t0 + 8 * w + i;
            const bf16* src = QKVI + (size_t)row * QKVI_LD;
#pragma unroll
            for (int j = 0; j < 5; ++j) {
                const int hh = j * 4 + grp, col = hh * 64 + 4 * sub;
                const u32x2 x = *(const u32x2*)(src + col);
                f32x4 v = (f32x4){bflo(x.x), bfhi(x.x), bflo(x.y), bfhi(x.y)};
                float ss = (v.x * v.x + v.y * v.y) + (v.z * v.z + v.w * v.w);
                ss = row16_sum(ss);
                const float rstd = __builtin_amdgcn_rsqf(ss * (1.f / 64.f) + 1e-6f);
                if (j < 4) { v = v * rstd * qn * QSCALE; u32x2 o; o.x = pk2(v.x, v.y); o.y = pk2(v.z, v.w); *(u32x2*)(QN + (size_t)row * D + col) = o; }
                else { v = v * rstd * kn; u32x2 o; o.x = pk2(v.x, v.y); o.y = pk2(v.z, v.w); *(u32x2*)(KN + (size_t)row * 256 + (col - 1024)) = o; }
            }
            {
                const u32x2 x = *(const u32x2*)(src + 2048 + 4 * sub);
                f32x4 v = (f32x4){bflo(x.x), bfhi(x.x), bflo(x.y), bfhi(x.y)};
                float ss = (v.x * v.x + v.y * v.y) + (v.z * v.z + v.w * v.w);
                ss = row16_sum(ss);
                const float rstd = __builtin_amdgcn_rsqf(ss * (1.f / 64.f) + 1e-6f);
                v = v * rstd * ikn;
                if (grp == 0) { u32x2 o; o.x = pk2(v.x, v.y); o.y = pk2(v.z, v.w); *(u32x2*)(IKN + (size_t)row * 64 + 4 * sub) = o; }
                if (lane < 8) IW[(size_t)row * 8 + lane] = bf2f(src[2112 + lane]) * IWSCALE;
            }
        }
        for (int task = tid; task < 64 * 64; task += NTHREADS) {
            const int tok = task >> 6, c4 = task & 63;
            const u32x2 x = *(const u32x2*)(QKVI + (size_t)(t0 + tok) * QKVI_LD + 1280 + 4 * c4);
            vt[(4 * c4 + 0) * 72 + tok] = (bf16)(x.x & 0xffffu); vt[(4 * c4 + 1) * 72 + tok] = (bf16)(x.x >> 16);
            vt[(4 * c4 + 2) * 72 + tok] = (bf16)(x.y & 0xffffu); vt[(4 * c4 + 3) * 72 + tok] = (bf16)(x.y >> 16);
        }
        __syncthreads();
        {
            const int col = tid >> 1, half = tid & 1;
            bf16* dst = VT + ((size_t)(b * 4 + (col >> 6)) * 64 + (col & 63)) * SEQ + tt0 + half * 32;
#pragma unroll
            for (int i = 0; i < 4; ++i) *(u32x4*)(dst + 8 * i) = *(const u32x4*)(vt + col * 72 + half * 32 + 8 * i);
        }
        __syncthreads();
    }
}

__device__ __forceinline__ u64 cmp_ge_mask(unsigned v, unsigned c) { u64 m; asm("v_cmp_ge_u32_e64 %0, %1, %2" : "=s"(m) : "v"(v), "s"(c)); return m; }
__device__ __forceinline__ unsigned f2key(float f) { const unsigned u = __builtin_bit_cast(unsigned, f); return (u & 0x80000000u) ? ~u : (u | 0x80000000u); }

template <bool DO_SELECT> __device__ __forceinline__ void dsa_index(const Args& a, unsigned char* lds, int tid) {
    asm volatile("" : "+v"(tid));
    unsigned char* ws = a.ws;
    const bf16* QKVI = (const bf16*)(ws + WS_QKVI); const bf16* IKN = (const bf16*)(ws + WS_IKN); const float* IW = (const float*)(ws + WS_IW);
    u64* MASK = (u64*)(ws + WS_MASK);
    float* scl = (float*)lds;
    const int lane = tid & 63, w = __builtin_amdgcn_readfirstlane(tid >> 6), hi = lane >> 5, l32 = lane & 31;
    const int G = gridDim.x;
    for (int r = blockIdx.x; r < M / 8; r += G) {
        const int b = r >> 9; int qi = r & 511; if ((r >> 9) & 1) qi = 511 - qi;
        const int q0 = qi * 8, nch = (q0 >> 6) + 1;
        const size_t rowb = (size_t)b * SEQ;
        const int a_ql = 2 * ((l32 >> 2) & 1) + (l32 >> 4), a_h = ((l32 >> 3) & 1) * 4 + (l32 & 3);
        bf16x8 af[2][4];
#pragma unroll
        for (int rb = 0; rb < 2; ++rb)
#pragma unroll
            for (int ks = 0; ks < 4; ++ks)
                af[rb][ks] = *(const bf16x8*)(QKVI + (rowb + q0 + rb * 4 + a_ql) * QKVI_LD + 1536 + a_h * 64 + 16 * ks + 8 * hi);
        f32x4 iwv[2][2][2];
#pragma unroll
        for (int rb = 0; rb < 2; ++rb)
#pragma unroll
            for (int jj = 0; jj < 2; ++jj) { const float* ip = IW + (rowb + q0 + rb * 4 + 2 * hi + jj) * 8; iwv[rb][jj][0] = *(const f32x4*)ip; iwv[rb][jj][1] = *(const f32x4*)(ip + 4); }
        for (int ch = w; ch < nch; ch += 8) {
#pragma unroll
            for (int cb = 0; cb < 2; ++cb) {
                bf16x8 bfr[4];
#pragma unroll
                for (int ks = 0; ks < 4; ++ks) bfr[ks] = *(const bf16x8*)(IKN + (rowb + ch * 64 + cb * 32 + l32) * 64 + 16 * ks + 8 * hi);
                const int key = ch * 64 + cb * 32 + l32;
#pragma unroll
                for (int rb = 0; rb < 2; ++rb) {
                    f32x16 acc;
#pragma unroll
                    for (int e = 0; e < 16; ++e) acc[e] = 0.f;
#pragma unroll
                    for (int ks = 0; ks < 4; ++ks) acc = __builtin_amdgcn_mfma_f32_32x32x16_bf16(af[rb][ks], bfr[ks], acc, 0, 0, 0);
#pragma unroll
                    for (int jj = 0; jj < 2; ++jj) {
                        float sc = 0.f;
#pragma unroll
                        for (int e = 0; e < 8; ++e) sc = fmaf(fmaxf(acc[8 * jj + e], 0.f), iwv[rb][jj][e >> 2][e & 3], sc);
                        const int q = rb * 4 + 2 * hi + jj;
                        if (key > q0 + q) sc = -INFINITY;
                        scl[q * SEQ + key] = sc;
                    }
                }
            }
        }
        __syncthreads();
        if (DO_SELECT) {
            const int q = q0 + w, nreg = (q >> 6) + 1;
            unsigned u[64];
#pragma unroll
            for (int i = 0; i < 64; ++i) {
                unsigned v = 0u;
                if (i < nreg) { const int key = i * 64 + lane; const float f = scl[w * SEQ + key]; v = (key <= q) ? f2key(f) : 0u; }
                u[i] = v;
            }
            u64 myword = 0ull;
            if (q + 1 <= 256) {
#pragma unroll
                for (int i = 0; i < 64; ++i) { const u64 wd = __ballot(i * 64 + lane <= q); if (lane == i) myword = wd; }
            } else {
                unsigned prefix = 0u, ecand = 0u; bool exact = false;
                for (int bit = 31; bit >= 0; --bit) {
                    const unsigned cand = prefix | (1u << bit);
                    int cnt = 0;
#pragma unroll
                    for (int g = 0; g < 8; ++g) {
                        if (g * 8 < nreg) {
                            u64 m0, m1, m2, m3, m4, m5, m6, m7;
                            asm("v_cmp_ge_u32_e64 %0, %8, %16\n\tv_cmp_ge_u32_e64 %1, %9, %16\n\tv_cmp_ge_u32_e64 %2, %10, %16\n\tv_cmp_ge_u32_e64 %3, %11, %16\n\t"
                                "v_cmp_ge_u32_e64 %4, %12, %16\n\tv_cmp_ge_u32_e64 %5, %13, %16\n\tv_cmp_ge_u32_e64 %6, %14, %16\n\tv_cmp_ge_u32_e64 %7, %15, %16"
                                : "=&s"(m0), "=&s"(m1), "=&s"(m2), "=&s"(m3), "=&s"(m4), "=&s"(m5), "=&s"(m6), "=&s"(m7)
                                : "v"(u[g * 8 + 0]), "v"(u[g * 8 + 1]), "v"(u[g * 8 + 2]), "v"(u[g * 8 + 3]), "v"(u[g * 8 + 4]), "v"(u[g * 8 + 5]), "v"(u[g * 8 + 6]), "v"(u[g * 8 + 7]), "s"(cand));
                            cnt += (__builtin_popcountll(m0) + __builtin_popcountll(m1)) + (__builtin_popcountll(m2) + __builtin_popcountll(m3))
                                 + (__builtin_popcountll(m4) + __builtin_popcountll(m5)) + (__builtin_popcountll(m6) + __builtin_popcountll(m7));
                        }
                    }
                    if (cnt == 256) { exact = true; ecand = cand; break; }
                    if (cnt > 256) prefix = cand;
                }
                if (exact) {
#pragma unroll
                    for (int i = 0; i < 64; ++i) { const u64 wd = __ballot(u[i] >= ecand); if (lane == i) myword = wd; }
                } else {
                    const unsigned T = prefix;
                    int ngt = 0;
#pragma unroll
                    for (int i = 0; i < 64; ++i) ngt += __builtin_popcountll(__ballot(u[i] > T));
                    int need = 256 - ngt;
#pragma unroll
                    for (int i = 0; i < 64; ++i) {
                        const u64 gt = __ballot(u[i] > T); u64 eq = __ballot(u[i] == T);
                        while (__builtin_popcountll(eq) > need) eq &= ~(1ull << (63 - __builtin_clzll(eq)));
                        need -= __builtin_popcountll(eq);
                        const u64 wd = gt | eq; if (lane == i) myword = wd;
                    }
                }
            }
            MASK[(rowb + q) * 64 + lane] = myword;
        }
        __syncthreads();
    }
}

template <int PV> __device__ __forceinline__ void dsa_attn(const Args& a, unsigned char* lds, int tid) {
    asm volatile("" : "+v"(tid));
    unsigned char* ws = a.ws;
    const bf16* QN = (const bf16*)(ws + WS_QN); const bf16* KN = (const bf16*)(ws + WS_KN); const bf16* VT = (const bf16*)(ws + WS_VT);
    const u64* MASK = (const u64*)(ws + WS_MASK);
    bf16* O = (bf16*)(ws + (PV == 0 ? WS_QN : WS_U));
    bf16* ksm = (bf16*)lds;
    bf16* vsm = (bf16*)(lds + 4 * 64 * 72 * 2);
    const int lane = tid & 63, w = __builtin_amdgcn_readfirstlane(tid >> 6), hi = lane >> 5, l32 = lane & 31;
    const int srow = tid >> 3, sc16 = tid & 7;
    float nB;
    { float mq = fabsf(a.in[I_QNORM][lane]), mk = fabsf(a.in[I_KNORM][lane]);
#pragma unroll
      for (int o = 1; o < 64; o <<= 1) { mq = fmaxf(mq, __shfl_xor(mq, o)); mk = fmaxf(mk, __shfl_xor(mk, o)); }
      nB = -(64.0f * QSCALE * 1.02f) * mq * mk; }
    for (int c = blockIdx.x; c < 256; c += gridDim.x)
    for (int k = 0; k < 8; ++k) {
        const int bg = (c >> 6) + 4 * k, b = bg >> 2, g = bg & 3;
        int qt = c & 63; if (k & 1) qt = 63 - qt;
        const int hq = g * 4 + (w & 3), qb = qt * 64 + (w >> 2) * 32 + l32;
        const size_t rowb = (size_t)b * SEQ;
        const int ntile = qt + 1;
        bf16x8 qf[4];
#pragma unroll
        for (int ks = 0; ks < 4; ++ks) qf[ks] = *(const bf16x8*)(QN + (rowb + qb) * D + hq * 64 + 16 * ks + 8 * hi);
        const bf16* kg = KN + (rowb + srow) * 256 + g * 64 + sc16 * 8;
        const bf16* vg = VT + ((size_t)(b * 4 + g) * 64 + srow) * SEQ + sc16 * 8;
        const u64* mrow = MASK + (rowb + qb) * 64;
        u32x4 kr0 = *(const u32x4*)kg, vr0 = *(const u32x4*)vg, kr1 = kr0, vr1 = vr0;
        if (ntile > 1) { kr1 = *(const u32x4*)(kg + (size_t)64 * 256); vr1 = *(const u32x4*)(vg + 64); }
        *(u32x4*)(ksm + srow * 72 + sc16 * 8) = kr0; *(u32x4*)(vsm + srow * 72 + sc16 * 8) = vr0;
        *(u32x4*)(ksm + 64 * 72 + srow * 72 + sc16 * 8) = kr1; *(u32x4*)(vsm + 64 * 72 + srow * 72 + sc16 * 8) = vr1;
        __syncthreads();
        f32x16 o0, o1;
#pragma unroll
        for (int e = 0; e < 16; ++e) { o0[e] = 0.f; o1[e] = 0.f; }
        float lsum = 0.f;
        u64 mwa = mrow[0], mwb = (ntile > 1) ? mrow[1] : 0ull;
#define ATT_QK(KB_, P0, P1) do { const bf16* kb_ = (KB_); \
            _Pragma("unroll") for (int e = 0; e < 16; ++e) { P0[e] = nB; P1[e] = nB; } \
            if (PV != 4) _Pragma("unroll") for (int ks = 0; ks < 4; ++ks) { \
                const bf16x8 ka = *(const bf16x8*)(kb_ + l32 * 72 + 16 * ks + 8 * hi); \
                const bf16x8 kc = *(const bf16x8*)(kb_ + (32 + l32) * 72 + 16 * ks + 8 * hi); \
                P0 = __builtin_amdgcn_mfma_f32_32x32x16_bf16(ka, qf[ks], P0, 0, 0, 0); \
                P1 = __builtin_amdgcn_mfma_f32_32x32x16_bf16(kc, qf[ks], P1, 0, 0, 0); } } while (0)
#define ATT_SM(MW_, P0, P1) do { const u64 mw = (MW_); \
            const unsigned m0 = (unsigned)mw >> (4 * hi), m1 = (unsigned)(mw >> 32) >> (4 * hi); \
            float ps = 0.f, ps2 = 0.f; \
            if (PV != 2) _Pragma("unroll") for (int v = 0; v < 16; ++v) { \
                const int cbit = 8 * (v >> 2) + (v & 3); \
                int t0, t1; asm("v_bfe_i32 %0, %1, %2, 1" : "=v"(t0) : "v"(m0), "n"(cbit)); asm("v_bfe_i32 %0, %1, %2, 1" : "=v"(t1) : "v"(m1), "n"(cbit)); \
                P0[v] = __builtin_bit_cast(float, __builtin_bit_cast(int, __builtin_amdgcn_exp2f(P0[v])) & t0); \
                P1[v] = __builtin_bit_cast(float, __builtin_bit_cast(int, __builtin_amdgcn_exp2f(P1[v])) & t1); \
                asm("v_add_f32 %0, %1, %0" : "+v"(ps) : "v"(P0[v])); asm("v_add_f32 %0, %1, %0" : "+v"(ps2) : "v"(P1[v])); } \
            lsum += ps + ps2; } while (0)
#define ATT_PV(VB_, P0, P1) do { const bf16* vb_ = (VB_); \
            if (PV == 3) { lsum += P0[0] + P1[5]; } else \
            _Pragma("unroll") for (int kb = 0; kb < 2; ++kb) \
            _Pragma("unroll") for (int s = 0; s < 2; ++s) { \
                    u32x4 pb; \
                    if (kb == 0) { pb.x = pk2(P0[8 * s + 0], P0[8 * s + 1]); pb.y = pk2(P0[8 * s + 2], P0[8 * s + 3]); pb.z = pk2(P0[8 * s + 4], P0[8 * s + 5]); pb.w = pk2(P0[8 * s + 6], P0[8 * s + 7]); } \
                    else         { pb.x = pk2(P1[8 * s + 0], P1[8 * s + 1]); pb.y = pk2(P1[8 * s + 2], P1[8 * s + 3]); pb.z = pk2(P1[8 * s + 4], P1[8 * s + 5]); pb.w = pk2(P1[8 * s + 6], P1[8 * s + 7]); } \
                    const bf16x8 pbv = __builtin_bit_cast(bf16x8, pb); \
                    const int base = kb * 32 + 16 * s + 4 * hi; \
                    { const u32x2 lo = *(const u32x2*)(vb_ + l32 * 72 + base), hi2 = *(const u32x2*)(vb_ + l32 * 72 + base + 8); \
                      const u32x4 va = (u32x4){lo.x, lo.y, hi2.x, hi2.y}; \
                      o0 = __builtin_amdgcn_mfma_f32_32x32x16_bf16(__builtin_bit_cast(bf16x8, va), pbv, o0, 0, 0, 0); } \
                    { const u32x2 lo = *(const u32x2*)(vb_ + (32 + l32) * 72 + base), hi2 = *(const u32x2*)(vb_ + (32 + l32) * 72 + base + 8); \
                      const u32x4 va = (u32x4){lo.x, lo.y, hi2.x, hi2.y}; \
                      o1 = __builtin_amdgcn_mfma_f32_32x32x16_bf16(__builtin_bit_cast(bf16x8, va), pbv, o1, 0, 0, 0); } } \
        } while (0)
        for (int j = 0; j < ntile; j += 2) {
            const int set = (j >> 1) & 1;
            const bool have2 = (j + 1 < ntile), more0 = (j + 2 < ntile), more1 = (j + 3 < ntile);
            if (more0) { kr0 = *(const u32x4*)(kg + (size_t)(j + 2) * 64 * 256); vr0 = *(const u32x4*)(vg + (j + 2) * 64); }
            if (more1) { kr1 = *(const u32x4*)(kg + (size_t)(j + 3) * 64 * 256); vr1 = *(const u32x4*)(vg + (j + 3) * 64); }
            const u64 mw0 = mwa, mw1 = mwb;
            if (more0) mwa = mrow[j + 2];
            if (more1) mwb = mrow[j + 3];
            const bf16* kA = ksm + (2 * set) * 64 * 72; const bf16* vA = vsm + (2 * set) * 64 * 72;
            const bf16* kB = kA + 64 * 72; const bf16* vB = vA + 64 * 72;
            f32x16 pa0, pa1;
            if (have2) {
                f32x16 pb0, pb1;
                if (w < 4) {
                    ATT_QK(kA, pa0, pa1); ATT_QK(kB, pb0, pb1); ATT_SM(mw0, pa0, pa1); ATT_PV(vA, pa0, pa1); ATT_SM(mw1, pb0, pb1); ATT_PV(vB, pb0, pb1);
                } else {
                    ATT_QK(kA, pa0, pa1); ATT_SM(mw0, pa0, pa1); ATT_QK(kB, pb0, pb1); ATT_PV(vA, pa0, pa1); ATT_SM(mw1, pb0, pb1); ATT_PV(vB, pb0, pb1);
                }
            } else { ATT_QK(kA, pa0, pa1); ATT_SM(mw0, pa0, pa1); ATT_PV(vA, pa0, pa1); }
            if (more0) { *(u32x4*)(ksm + (2 * (set ^ 1)) * 64 * 72 + srow * 72 + sc16 * 8) = kr0; *(u32x4*)(vsm + (2 * (set ^ 1)) * 64 * 72 + srow * 72 + sc16 * 8) = vr0; }
            if (more1) { *(u32x4*)(ksm + (2 * (set ^ 1) + 1) * 64 * 72 + srow * 72 + sc16 * 8) = kr1; *(u32x4*)(vsm + (2 * (set ^ 1) + 1) * 64 * 72 + srow * 72 + sc16 * 8) = vr1; }
            __syncthreads();
        }
#undef ATT_QK
#undef ATT_SM
#undef ATT_PV
        const float ltot = lsum + __shfl_xor(lsum, 32);
        const float inv = 1.0f / ltot;
        bf16* orow = O + (rowb + qb) * D + hq * 64 + 4 * hi;
#pragma unroll
        for (int v4 = 0; v4 < 4; ++v4) {
            u32x2 x; x.x = pk2(o0[4 * v4] * inv, o0[4 * v4 + 1] * inv); x.y = pk2(o0[4 * v4 + 2] * inv, o0[4 * v4 + 3] * inv);
            *(u32x2*)(orow + 8 * v4) = x;
            u32x2 y; y.x = pk2(o1[4 * v4] * inv, o1[4 * v4 + 1] * inv); y.y = pk2(o1[4 * v4 + 2] * inv, o1[4 * v4 + 3] * inv);
            *(u32x2*)(orow + 32 + 8 * v4) = y;
        }
    }
}

__device__ __forceinline__ void dsa_mixer(const Args& a, unsigned char* lds, const XcdBarrier& bar, const float* modl, int tid) {
    unsigned char* ws = a.ws;
    bf16* U = (bf16*)(ws + WS_U);
    float* PART = (float*)(ws + WS_PART); const float* BV = (const float*)(ws + WS_BIAS);
    { pg8::EpiBf16<3> E{(bf16*)(ws + WS_QKVI), DSA_N, PART, BV + BV_DSA}; run_gemm(lds, U, D, (const bf16*)(ws + WS_WDSAIN), M, DSA_N, D, E); }
    xcd_barrier(bar);
    for (int rep = 0; rep < REP_DPREP; ++rep) { dsa_prep(a, lds, tid); xcd_barrier(bar); }
#if defined(PROBE_NOSEL)
    dsa_index<false>(a, lds, tid); xcd_barrier(bar);
#endif
    for (int rep = 0; rep < REP_INDEX; ++rep) { dsa_index<true>(a, lds, tid); xcd_barrier(bar); }
#if defined(PROBE_ATTN)
    dsa_attn<PROBE_ATTN>(a, lds, tid); xcd_barrier(bar);
#endif
    dsa_attn<0>(a, lds, tid); xcd_barrier(bar);
    { pg8::EpiResid<true, false> E{a.out, a.out, modl + 5 * D, U, modl + 7 * D, PART}; run_gemm(lds, (const bf16*)(ws + WS_QN), D, (const bf16*)(ws + WS_WDSAOUT), M, D, D, E); }
    xcd_barrier(bar);
}
__device__ __forceinline__ float afma(float a, float b, float c) { float d; asm("v_fma_f32 %0, %1, %2, %3" : "=v"(d) : "v"(a), "v"(b), "v"(c)); return d; }
__device__ __forceinline__ float amul(float a, float b) { float d; asm("v_mul_f32 %0, %1, %2" : "=v"(d) : "v"(a), "v"(b)); return d; }
constexpr int EA_LD = 2048;
template <int PMODE> __device__ __forceinline__ void rwkv_scan(const Args& a, unsigned char* lds, int tid) {
    asm volatile("" : "+v"(tid));
    unsigned char* ws = a.ws;
    const bf16* RK = (const bf16*)(ws + WS_RK); const bf16* EA = (const bf16*)(ws + WS_A2); bf16* Y = (bf16*)(ws + WS_Y);
    float* vecs = (float*)lds;
    float* ybuf = (float*)(lds + 2 * 6 * 32 * 64 * 4);
    const int lane = tid & 63, w = __builtin_amdgcn_readfirstlane(tid >> 6), slice = lane & 15, rin = w * 4 + (lane >> 4);
    const int ts = tid >> 4, cgp = tid & 15;
    for (int unit = blockIdx.x; unit < 256; unit += gridDim.x) {
        const int chain = unit >> 1, half = unit & 1, b = chain >> 4, h = chain & 15;
        const size_t rowb = (size_t)b * SEQ;
        const f32x4 kkp = *(const f32x4*)(a.in[I_KK] + h * 64 + 4 * cgp), kap = *(const f32x4*)(a.in[I_KA] + h * 64 + 4 * cgp);
        u32x2 rr, rk, rv, re, ra;
#define SCAN_LOAD(c) do { const size_t row_ = rowb + (c) * 32 + ts; const bf16* p_ = RK + row_ * RW_N + h * 64 + 4 * cgp; \
            rr = *(const u32x2*)p_; rk = *(const u32x2*)(p_ + 1024); rv = *(const u32x2*)(p_ + 2048); \
            const bf16* q_ = EA + row_ * EA_LD + h * 64 + 4 * cgp; re = *(const u32x2*)q_; ra = *(const u32x2*)(q_ + 1024); } while (0)
#define SCAN_STORE(buf) do { float* base_ = vecs + (buf) * 6 * 2048 + ts * 64 + 4 * cgp; \
            const f32x4 r4 = (f32x4){bflo(rr.x), bfhi(rr.x), bflo(rr.y), bfhi(rr.y)}, k4 = (f32x4){bflo(rk.x), bfhi(rk.x), bflo(rk.y), bfhi(rk.y)}; \
            const f32x4 v4 = (f32x4){bflo(rv.x), bfhi(rv.x), bflo(rv.y), bfhi(rv.y)}, e4 = (f32x4){bflo(re.x), bfhi(re.x), bflo(re.y), bfhi(re.y)}; \
            const f32x4 a4 = (f32x4){bflo(ra.x), bfhi(ra.x), bflo(ra.y), bfhi(ra.y)}; \
            f32x4 w4; w4.x = __expf(-e4.x); w4.y = __expf(-e4.y); w4.z = __expf(-e4.z); w4.w = __expf(-e4.w); \
            const f32x4 kraw = k4 * kkp; float ss_ = (kraw.x * kraw.x + kraw.y * kraw.y) + (kraw.z * kraw.z + kraw.w * kraw.w); ss_ = row16_sum(ss_); \
            const float inv_ = __builtin_amdgcn_rsqf(fmaxf(ss_, 1e-24f)); const f32x4 kkn = kraw * inv_; \
            const f32x4 kt = k4 * ((a4 - 1.0f) * kap + 1.0f); const f32x4 bv = kkn * a4; \
            *(f32x4*)(base_) = r4; *(f32x4*)(base_ + 2048) = w4; *(f32x4*)(base_ + 2 * 2048) = kt; *(f32x4*)(base_ + 3 * 2048) = -kkn; \
            *(f32x4*)(base_ + 4 * 2048) = bv; *(f32x4*)(base_ + 5 * 2048) = v4; } while (0)
        SCAN_LOAD(0); SCAN_STORE(0);
        __syncthreads();
        float s0 = 0.f, s1 = 0.f, s2 = 0.f, s3 = 0.f;
        for (int c = 0; c < SEQ / 32; ++c) {
            const int buf = c & 1;
            if (c + 1 < SEQ / 32) SCAN_LOAD(c + 1);
            if (PMODE != 1) {
                const float* vb = vecs + buf * 6 * 2048 + 4 * slice;
                const float* vv = vecs + buf * 6 * 2048 + 5 * 2048 + half * 32 + rin;
                float* yb = ybuf + buf * 4096 + rin * 4 + (slice >> 2);
                f32x4 r4 = *(const f32x4*)(vb), w4 = *(const f32x4*)(vb + 2048), k4 = *(const f32x4*)(vb + 2 * 2048);
                f32x4 n4 = *(const f32x4*)(vb + 3 * 2048), b4 = *(const f32x4*)(vb + 4 * 2048);
                float v1 = *vv;
#pragma unroll 8
                for (int t = 0; t < 32; ++t) {
                    const int tn = (t + 1) & 31;
                    const f32x4 r4n = *(const f32x4*)(vb + tn * 64), w4n = *(const f32x4*)(vb + 2048 + tn * 64), k4n = *(const f32x4*)(vb + 2 * 2048 + tn * 64);
                    const f32x4 n4n = *(const f32x4*)(vb + 3 * 2048 + tn * 64), b4n = *(const f32x4*)(vb + 4 * 2048 + tn * 64);
                    const float v1n = vv[tn * 64];
                    float sa = afma(s1, n4.y, amul(s0, n4.x)) + afma(s3, n4.w, amul(s2, n4.z));
                    sa = row16_sum(sa);
                    s0 = afma(s0, w4.x, amul(b4.x, sa)); s1 = afma(s1, w4.y, amul(b4.y, sa)); s2 = afma(s2, w4.z, amul(b4.z, sa)); s3 = afma(s3, w4.w, amul(b4.w, sa));
                    s0 = afma(k4.x, v1, s0); s1 = afma(k4.y, v1, s1); s2 = afma(k4.z, v1, s2); s3 = afma(k4.w, v1, s3);
                    float y = afma(s1, r4.y, amul(s0, r4.x)) + afma(s3, r4.w, amul(s2, r4.z));
                    y += dppf<0xB1>(y); y += dppf<0x4E>(y);
                    yb[t * 128] = y;
                    r4 = r4n; w4 = w4n; k4 = k4n; n4 = n4n; b4 = b4n; v1 = v1n;
                }
            }
            if (c + 1 < SEQ / 32) SCAN_STORE(buf ^ 1);
            __syncthreads();
            {
                const f32x4 ya = *(const f32x4*)(ybuf + buf * 4096 + ts * 128 + 8 * cgp), yb4 = *(const f32x4*)(ybuf + buf * 4096 + ts * 128 + 8 * cgp + 4);
                *(unsigned*)(Y + (rowb + c * 32 + ts) * D + h * 64 + half * 32 + 2 * cgp) = pk2((ya.x + ya.y) + (ya.z + ya.w), (yb4.x + yb4.y) + (yb4.z + yb4.w));
            }
        }
        __syncthreads();
#undef SCAN_LOAD
#undef SCAN_STORE
    }
}

__device__ __forceinline__ void rwkv_post(const Args& a, int tid) {
    asm volatile("" : "+v"(tid));
    unsigned char* ws = a.ws;
    const bf16* RK = (const bf16*)(ws + WS_RK); const bf16* EA = (const bf16*)(ws + WS_A2); bf16* Y = (bf16*)(ws + WS_Y);
    const int lane = tid & 63, sub = lane & 15, grp = lane >> 4;
    const int gw = blockIdx.x * 8 + (tid >> 6), NGW = gridDim.x * 8;
    for (int row = gw; row < M; row += NGW) {
#pragma unroll
        for (int pass = 0; pass < 4; ++pass) {
            const int c = (pass * 4 + grp) * 64 + 4 * sub;
            const u32x2 yy = *(const u32x2*)(Y + (size_t)row * D + c);
            const bf16* p = RK + (size_t)row * RW_N + c;
            const u32x2 rr = *(const u32x2*)p, rk = *(const u32x2*)(p + 1024), rv = *(const u32x2*)(p + 2048);
            const u32x2 gg = *(const u32x2*)(EA + (size_t)row * EA_LD + c), aa = *(const u32x2*)(EA + (size_t)row * EA_LD + 1024 + c);
            const f32x4 y4 = (f32x4){bflo(yy.x), bfhi(yy.x), bflo(yy.y), bfhi(yy.y)};
            const f32x4 r4 = (f32x4){bflo(rr.x), bfhi(rr.x), bflo(rr.y), bfhi(rr.y)}, k4 = (f32x4){bflo(rk.x), bfhi(rk.x), bflo(rk.y), bfhi(rk.y)};
            const f32x4 v4 = (f32x4){bflo(rv.x), bfhi(rv.x), bflo(rv.y), bfhi(rv.y)}, g4 = (f32x4){bflo(gg.x), bfhi(gg.x), bflo(gg.y), bfhi(gg.y)};
            const f32x4 a4 = (f32x4){bflo(aa.x), bfhi(aa.x), bflo(aa.y), bfhi(aa.y)};
            const f32x4 kap = *(const f32x4*)(a.in[I_KA] + c), rkp = *(const f32x4*)(a.in[I_RK] + c), lw = *(const f32x4*)(a.in[I_LNW] + c), lb = *(const f32x4*)(a.in[I_LNB] + c);
            const float mean = row16_sum((y4.x + y4.y) + (y4.z + y4.w)) * (1.f / 64.f);
            const f32x4 d4 = y4 - mean;
            const float var = row16_sum((d4.x * d4.x + d4.y * d4.y) + (d4.z * d4.z + d4.w * d4.w)) * (1.f / 64.f);
            const float rstd = __builtin_amdgcn_rsqf(var + 64e-5f);
            const f32x4 kt = k4 * ((a4 - 1.0f) * kap + 1.0f);
            const f32x4 rkk = r4 * kt * rkp;
            const float sd = row16_sum((rkk.x + rkk.y) + (rkk.z + rkk.w));
            const f32x4 o = ((d4 * rstd) * lw + lb + v4 * sd) * g4;
            u32x2 ov; ov.x = pk2(o.x, o.y); ov.y = pk2(o.z, o.w);
            *(u32x2*)(Y + (size_t)row * D + c) = ov;
        }
    }
}

__device__ __forceinline__ void rwkv_mixer(const Args& a, unsigned char* lds, const XcdBarrier& bar, const float* modl, int tid) {
    unsigned char* ws = a.ws;
    bf16* A2 = (bf16*)(ws + WS_A2); bf16* RK = (bf16*)(ws + WS_RK); bf16* Y = (bf16*)(ws + WS_Y);
    const bf16* WL = (const bf16*)(ws + WS_WLORA);
    norm_phase(a.out, modl, 1, A2, 1, tid);
    xcd_barrier(bar);
    for (int rep = 0; rep < REP_RWIN; ++rep) { pg8::EpiBf16<1> E{RK, RW_N, nullptr, nullptr}; run_gemm(lds, A2, RW_K, (const bf16*)(ws + WS_WRWIN), M, RW_N, RW_K, E); xcd_barrier(bar); }
    { pg8::EpiBf16<2> E{A2, EA_LD, a.in[I_W0], a.in[I_A0]}; run_gemm(lds, RK + 3072, RW_N, WL, M, 2048, LORA_K, E); }
    xcd_barrier(bar);
    #if defined(PROBE_SCAN_STAGE)
    rwkv_scan<1>(a, lds, tid); xcd_barrier(bar);
#endif
    for (int rep = 0; rep < REP_SCAN; ++rep) { rwkv_scan<0>(a, lds, tid); xcd_barrier(bar); }
    { pg8::EpiBf16<0> E{A2, EA_LD, nullptr, nullptr}; run_gemm(lds, RK + 3072, RW_N, WL + (size_t)2048 * LORA_K, M, 1024, LORA_K, E); }
    xcd_barrier(bar);
    rwkv_post(a, tid);
    xcd_barrier(bar);
    { pg8::EpiResid<true, false> E{a.out, a.out, modl + 5 * D, (bf16*)(ws + WS_U), modl + 7 * D, (float*)(ws + WS_PART)}; run_gemm(lds, Y, D, (const bf16*)(ws + WS_WRWOUT), M, D, D, E); }
    xcd_barrier(bar);
}

#ifndef REP_P0
#define REP_P0 1
#endif
#ifndef REP_NORM
#define REP_NORM 1
#endif
#ifndef REP_DOWN
#define REP_DOWN 1
#endif
#ifndef REP_GU
#define REP_GU 1
#endif
#ifndef ENABLE_DSA
#define ENABLE_DSA 1
#endif
#ifndef ENABLE_RWKV
#define ENABLE_RWKV 1
#endif
template <int L> __device__ __forceinline__ void layer_body(const Args& a, unsigned char* lds, const XcdBarrier& bar, int tid) {
    unsigned char* ws = a.ws;
    const float* MOD = (const float*)(ws + WS_MOD);
    bf16* U = (bf16*)(ws + WS_U);
    bf16* ACT = (bf16*)(ws + WS_ACT);
    float* H = a.out;
    float* PART = (float*)(ws + WS_PART); const float* BV = (const float*)(ws + WS_BIAS);
#define GSYNC() xcd_barrier(bar)

        const float* modl = MOD + (size_t)L * 8 * NMOD;
        const bf16* wgu0 = (const bf16*)(ws + (L == 0 ? WS_WGU0 : WS_WGU1));
        const bf16* wdn0 = (const bf16*)(ws + (L == 0 ? WS_WDN0 : WS_WDN1));
        if (L == 0) { for (int rep = 0; rep < REP_GU; ++rep) { pg8::EpiSwiglu<false> E{ACT, DFF, nullptr, nullptr}; run_gemm(lds, U, D, wgu0, M, 2 * DFF, D, E); GSYNC(); } }
        else { pg8::EpiSwiglu<true> E{ACT, DFF, PART, BV + BV_GU1A}; run_gemm(lds, U, D, wgu0, M, 2 * DFF, D, E); GSYNC(); }
        if (L == 0) {
            for (int rep = 0; rep < REP_DOWN; ++rep) { pg8::EpiResid<true, true> E{a.in[I_X], H, modl + 2 * D, U, modl + 4 * D, PART}; run_gemm(lds, ACT, DFF, wdn0, M, D, DFF, E); GSYNC(); }
            dsa_mixer(a, lds, bar, modl, tid);
        } else {
            { pg8::EpiResid<false, true> E{H, H, modl + 2 * D, nullptr, nullptr, nullptr}; run_gemm(lds, ACT, DFF, wdn0, M, D, DFF, E); }
            GSYNC();
            rwkv_mixer(a, lds, bar, modl, tid);
        }
        { pg8::EpiSwiglu<true> E{ACT, DFF, PART, BV + (L == 0 ? BV_GU0B : BV_GU1B)}; run_gemm(lds, U, D, wgu0 + (size_t)2 * DFF * D, M, 2 * DFF, D, E); }
        GSYNC();
        if (L == 0) { pg8::EpiResid<true, true> E{H, H, modl + 8 * D, U, MOD + (size_t)8 * NMOD + D, PART}; run_gemm(lds, ACT, DFF, wdn0 + (size_t)D * DFF, M, D, DFF, E); }
        else { pg8::EpiResid<false, true> E{H, H, modl + 8 * D, nullptr, nullptr, nullptr}; run_gemm(lds, ACT, DFF, wdn0 + (size_t)D * DFF, M, D, DFF, E); }
        GSYNC();

#undef GSYNC
}
__global__ void __launch_bounds__(NTHREADS, 2) mega_fwd(Args a) {
    extern __shared__ __attribute__((aligned(16))) unsigned char lds[];
    cg::grid_group grid = cg::this_grid();
    const int tid = threadIdx.x;
    unsigned char* ws = a.ws;
    const float* MOD = (const float*)(ws + WS_MOD);
    bf16* U = (bf16*)(ws + WS_U);
    bf16* ACT = (bf16*)(ws + WS_ACT);
    float* H = a.out;

    if (tid < 2) ((volatile LAS unsigned*)((LAS unsigned char*)lds + XB_LDS_OFF))[tid] = 0u;
    __syncthreads();
    for (int rep = 0; rep < REP_P0; ++rep) { p0_prep(a, lds, tid); grid.sync(); }
    const XcdBarrier bar = xcd_barrier_post((unsigned*)(ws + WS_BAR), (volatile LAS unsigned*)((LAS unsigned char*)lds + XB_LDS_OFF));
#define GSYNC() xcd_barrier(bar)

    float* PART = (float*)(ws + WS_PART); const float* BV = (const float*)(ws + WS_BIAS);
    for (int rep = 0; rep < REP_NORM; ++rep) { norm_phase(a.in[I_X], MOD, 0, U, 0, tid); bias_phase(ws, tid); GSYNC(); }
    layer_body<0>(a, lds, bar, tid);
    layer_body<1>(a, lds, bar, tid);
}

extern "C" void kernel_launch(void* const* d_in, const int* in_sizes, int n_in, void* d_out, int out_size, void* d_ws, size_t ws_size, hipStream_t stream) {
    static int grid = 0;
    if (grid == 0) {
        if (n_in != 27 || out_size != M * D || ws_size < WS_NEED) { fprintf(stderr, "kernel_launch: unexpected shapes (n_in %d out %d ws %zu)\n", n_in, out_size, ws_size); grid = -1; return; }
        int dev = 0, cus = 0, per_cu = 0;
        hipGetDevice(&dev);
        hipDeviceGetAttribute(&cus, hipDeviceAttributeMultiprocessorCount, dev);
        hipFuncSetAttribute((const void*)mega_fwd, hipFuncAttributeMaxDynamicSharedMemorySize, LDS_BYTES);
        hipOccupancyMaxActiveBlocksPerMultiprocessor(&per_cu, (const void*)mega_fwd, NTHREADS, LDS_BYTES);
        if (per_cu < 1) per_cu = 1;
        grid = cus * per_cu;
        (void)hipGetLastError();
    }
    if (grid < 0) return;
    Args a{};
    for (int i = 0; i < 27; ++i) a.in[i] = (const float*)d_in[i];
    a.out = (float*)d_out; a.ws = (unsigned char*)d_ws;
    void* args[] = {&a};
    hipError_t e = hipLaunchCooperativeKernel((void*)mega_fwd, dim3(grid), dim3(NTHREADS), args, LDS_BYTES, stream);
    if (e != hipSuccess) fprintf(stderr, "cooperative launch failed: %s (grid %d)\n", hipGetErrorString(e), grid);
}
```

```cpp
#include <hip/hip_runtime.h>
#include <hip/hip_cooperative_groups.h>
#include <cstdio>
#include <cstdint>
namespace cg = cooperative_groups;
namespace pg8 {
#define PG8_LAS __attribute__((address_space(3)))
typedef unsigned short bf16_t;
typedef short bf16x8 __attribute__((ext_vector_type(8)));
typedef float f32x4 __attribute__((ext_vector_type(4)));
typedef unsigned u32x4 __attribute__((ext_vector_type(4)));
constexpr int BM = 256, BK = 64, HALF = 128, HTB = HALF * BK * 2  , STAGE_BYTES = 8 * HTB, NXCD = 8, WGM = 8;

__host__ __device__ __forceinline__ int lds_byte(int r, int c) { const int st = (r >> 4) * 2 + (c >> 5), rr = r & 15, cc = c & 31, ob = rr * 64 + cc * 2; return st * 1024 + (ob ^ (((ob >> 9) & 1) << 5)); }
__host__ __device__ __forceinline__ void stage_rc(int b, int& R, int& C) { const int st = b / 1024, sb = b % 1024, swz = sb ^ (((sb >> 9) & 1) << 5); R = (st >> 1) * 16 + swz / 64; C = (st & 1) * 32 + (swz % 64) / 2; }
__host__ __device__ __forceinline__ int perm32(int rho) { const int n = rho >> 4, i = rho & 15; return 8 * (i >> 2) + 4 * n + (i & 3); }

struct Unit { int pm, pn; };
struct Gemm { const bf16_t* A; const bf16_t* Bt; int M, N, K, lda; };

struct StaticOrder {
    int nM, nN, nwg, G, c;
    __host__ __device__ void init(int M, int N, int G_, int c_) { nM = M / BM; nN = N / BM; nwg = nM * nN; G = G_; c = c_; }
    __host__ __device__ bool next(int i, Unit& u) const {
        const long L = (long)i * G + c; if (L >= nwg) return false;
        int wgid = (int)L; { const int q = nwg / NXCD, r = nwg % NXCD, xcd = wgid % NXCD, off = wgid / NXCD; wgid = (xcd < r ? xcd * (q + 1) : r * (q + 1) + (xcd - r) * q) + off; }
        const int nig = WGM * nN, gid = wgid / nig, fm = gid * WGM, gsz = (nM - fm) < WGM ? (nM - fm) : WGM;
        u.pm = fm + ((wgid % nig) % gsz); u.pn = (wgid % nig) / gsz; return true;
    }
    __device__ __forceinline__ void a_ready(const Unit&) const {}
    __device__ __forceinline__ void done(const Unit&) const {}
};

__device__ __forceinline__ unsigned cvt_pk_bf16(float lo, float hi) { unsigned r; asm volatile("v_cvt_pk_bf16_f32 %0, %1, %2" : "=v"(r) : "v"(lo), "v"(hi)); return r; }
template <class Epi, class Sched, bool ALIGN_EPI = false, bool SP2 = false>
__device__ __forceinline__ void gemm_phase(PG8_LAS unsigned char* lds, const Gemm g, const Sched& S, const Epi& E) {
    int tid_ = threadIdx.x; asm volatile("" : "+v"(tid_));
    const int tid = tid_, wid = __builtin_amdgcn_readfirstlane(tid >> 6), lane = tid & 63, wr = wid >> 2, wc = wid & 3, fr = lane & 15, fq = lane >> 4;
    const int K = g.K, nt = K / BK;
    unsigned voffA[2], voffB[2];
#pragma unroll
    for (int i = 0; i < 2; ++i) { int R, C; stage_rc(tid * 16 + i * 8192, R, C); const int Rb = Epi::PERM ? ((R & ~31) + perm32(R & 31)) : R;
        voffA[i] = (unsigned)(R * g.lda + C) * 2u; voffB[i] = (unsigned)(Rb * K + C) * 2u; }
    const size_t kstep = (size_t)(BK * 2);
    const size_t hstepA = (size_t)HALF * g.lda * 2, hstepB = (size_t)HALF * K * 2;
    const size_t tstepA = 2 * hstepA, tstepB = 2 * hstepB;
    const unsigned ldsw = (unsigned)wid * 1024u;
    const int aoff = lds_byte(wr * 64 + fr, fq * 8), boff = lds_byte(wc * 32 + fr, fq * 8);
#define PG8_SA(b, h) (((b) * 2 + (h)) * HTB)
#define PG8_SB(b, h) ((4 + (b) * 2 + (h)) * HTB)
#define PG8_STAGE(bufoff, gbase, voff) do { _Pragma("unroll") for (int _i = 0; _i < 2; ++_i) \
        __builtin_amdgcn_global_load_lds((const unsigned*)((const char*)(gbase) + (voff)[_i]), (PG8_LAS unsigned*)(lds + (bufoff) + ldsw + _i * 8192), 16, 0, 0); } while (0)
#define PG8_LDA(dst, b, h) do { _Pragma("unroll") for (int m = 0; m < 4; ++m) _Pragma("unroll") for (int k = 0; k < 2; ++k) dst[m][k] = *(const PG8_LAS bf16x8*)(lds + PG8_SA(b, h) + aoff + m * 2048 + k * 1024); } while (0)
#define PG8_LDB(dst, b, h) do { _Pragma("unroll") for (int n = 0; n < 2; ++n) _Pragma("unroll") for (int k = 0; k < 2; ++k) dst[n][k] = *(const PG8_LAS bf16x8*)(lds + PG8_SB(b, h) + boff + n * 2048 + k * 1024); } while (0)
#define PG8_MMA(ai, bj, At, Bt) do { __builtin_amdgcn_s_setprio(1); _Pragma("unroll") for (int m = 0; m < 4; ++m) _Pragma("unroll") for (int n = 0; n < 2; ++n) _Pragma("unroll") for (int k = 0; k < 2; ++k) \
        acc[ai][bj][m][n] = __builtin_amdgcn_mfma_f32_16x16x32_bf16(Bt[n][k], At[m][k], acc[ai][bj][m][n], 0, 0, 0); __builtin_amdgcn_s_setprio(0); } while (0)
#define PG8_WAIT_V(n) asm volatile("s_waitcnt vmcnt(" #n ")" ::: "memory")
#define PG8_WAIT_L(n) asm volatile("s_waitcnt lgkmcnt(" #n ")" ::: "memory")
#define PG8_BAR __builtin_amdgcn_s_barrier()
#define PG8_SCHED __builtin_amdgcn_sched_barrier(0)
    Unit cur, nxt; int ui = 0;
    if (!S.next(0, cur)) return;
    f32x4 acc[2][2][4][2];
#pragma unroll
    for (int a = 0; a < 2; ++a)
#pragma unroll
        for (int b = 0; b < 2; ++b)
#pragma unroll
            for (int m = 0; m < 4; ++m)
#pragma unroll
                for (int n = 0; n < 2; ++n) acc[a][b][m][n] = (f32x4){0.f, 0.f, 0.f, 0.f};
    bf16x8 At[4][2], B0[2][2], B1[2][2];
    const char* cA = (const char*)g.A + (size_t)cur.pm * tstepA; const char* cB = (const char*)g.Bt + (size_t)cur.pn * tstepB;
    S.a_ready(cur);
    if constexpr (SP2) {
        PG8_STAGE(PG8_SB(0, 0), cB, voffB); PG8_STAGE(PG8_SB(0, 1), cB + hstepB, voffB); PG8_STAGE(PG8_SA(0, 0), cA, voffA); PG8_STAGE(PG8_SA(0, 1), cA + hstepA, voffA);
        if (wr == 1) PG8_BAR;
        PG8_WAIT_V(2); PG8_BAR;
        PG8_STAGE(PG8_SB(1, 0), cB + kstep, voffB); PG8_STAGE(PG8_SA(1, 0), cA + kstep, voffA); PG8_STAGE(PG8_SB(1, 1), cB + hstepB + kstep, voffB);
        PG8_WAIT_V(6); PG8_BAR;
    } else {
        PG8_STAGE(PG8_SB(0, 0), cB, voffB); PG8_STAGE(PG8_SA(0, 0), cA, voffA); PG8_STAGE(PG8_SB(0, 1), cB + hstepB, voffB); PG8_STAGE(PG8_SA(0, 1), cA + hstepA, voffA);
        if (wr == 1) PG8_BAR;
        PG8_WAIT_V(4); PG8_BAR;
        PG8_STAGE(PG8_SB(1, 0), cB + kstep, voffB); PG8_STAGE(PG8_SA(1, 0), cA + kstep, voffA); PG8_STAGE(PG8_SB(1, 1), cB + hstepB + kstep, voffB);
        PG8_WAIT_V(6); PG8_BAR;
    }
    for (;;) {
        const bool has_next = S.next(ui + 1, nxt);
        const char* nA = has_next ? (const char*)g.A + (size_t)nxt.pm * tstepA : cA; const char* nB = has_next ? (const char*)g.Bt + (size_t)nxt.pn * tstepB : cB;
        for (int t = 0; t < nt; t += 2) {
            const bool last = (t == nt - 2);
            const char* a1 = cA + (size_t)(t + 1) * kstep;
            const char* a2 = last ? nA : cA + (size_t)(t + 2) * kstep; const char* b2 = last ? nB : cB + (size_t)(t + 2) * kstep;
            const char* a3 = a2 + kstep; const char* b3 = b2 + kstep;
            if (last && has_next) S.a_ready(nxt);
            if constexpr (SP2) {
            PG8_LDB(B0, 0, 0); PG8_LDB(B1, 0, 1); PG8_SCHED; PG8_LDA(At, 0, 0); PG8_STAGE(PG8_SA(1, 1), a1 + hstepA, voffA);
            PG8_WAIT_V(8); PG8_WAIT_L(0); PG8_BAR; PG8_MMA(0, 0, At, B0); PG8_MMA(0, 1, At, B1); PG8_BAR; PG8_SCHED;
            PG8_LDA(At, 0, 1); PG8_STAGE(PG8_SB(0, 0), b2, voffB); PG8_STAGE(PG8_SB(0, 1), b2 + hstepB, voffB); PG8_STAGE(PG8_SA(0, 0), a2, voffA);
            PG8_WAIT_V(8); PG8_WAIT_L(0); PG8_BAR; PG8_MMA(1, 0, At, B0); PG8_MMA(1, 1, At, B1); PG8_BAR; PG8_SCHED;
            PG8_LDB(B0, 1, 0); PG8_LDB(B1, 1, 1); PG8_SCHED; PG8_LDA(At, 1, 0); PG8_STAGE(PG8_SA(0, 1), a2 + hstepA, voffA);
            PG8_WAIT_V(8); PG8_WAIT_L(0); PG8_BAR; PG8_MMA(0, 0, At, B0); PG8_MMA(0, 1, At, B1); PG8_BAR; PG8_SCHED;
            PG8_LDA(At, 1, 1); PG8_STAGE(PG8_SB(1, 0), b3, voffB); PG8_STAGE(PG8_SB(1, 1), b3 + hstepB, voffB); PG8_STAGE(PG8_SA(1, 0), a3, voffA);
            PG8_WAIT_V(8); PG8_WAIT_L(0); PG8_BAR; PG8_MMA(1, 0, At, B0); PG8_MMA(1, 1, At, B1); PG8_BAR; PG8_SCHED;
            } else {
            PG8_LDB(B0, 0, 0); PG8_SCHED; PG8_LDA(At, 0, 0); PG8_STAGE(PG8_SA(1, 1), a1 + hstepA, voffA);
            PG8_WAIT_L(8); PG8_BAR; PG8_WAIT_L(0); PG8_MMA(0, 0, At, B0); PG8_BAR; PG8_SCHED;
            PG8_LDB(B1, 0, 1); PG8_STAGE(PG8_SB(0, 0), b2, voffB);
            PG8_BAR; PG8_WAIT_L(0); PG8_MMA(0, 1, At, B1); PG8_BAR;
            PG8_LDA(At, 0, 1); PG8_STAGE(PG8_SA(0, 0), a2, voffA);
            PG8_BAR; PG8_WAIT_L(0); PG8_MMA(1, 0, At, B0); PG8_BAR; PG8_SCHED;
            PG8_STAGE(PG8_SB(0, 1), b2 + hstepB, voffB);
            PG8_WAIT_V(6); PG8_BAR; PG8_MMA(1, 1, At, B1); PG8_BAR;
            PG8_LDB(B0, 1, 0); PG8_SCHED; PG8_LDA(At, 1, 0); PG8_STAGE(PG8_SA(0, 1), a2 + hstepA, voffA);
            PG8_WAIT_L(8); PG8_BAR; PG8_WAIT_L(0); PG8_MMA(0, 0, At, B0); PG8_BAR; PG8_SCHED;
            PG8_LDB(B1, 1, 1); PG8_STAGE(PG8_SB(1, 0), b3, voffB);
            PG8_BAR; PG8_WAIT_L(0); PG8_MMA(0, 1, At, B1); PG8_BAR;
            PG8_LDA(At, 1, 1); PG8_STAGE(PG8_SA(1, 0), a3, voffA);
            PG8_BAR; PG8_WAIT_L(0); PG8_MMA(1, 0, At, B0); PG8_BAR; PG8_SCHED;
            PG8_STAGE(PG8_SB(1, 1), b3 + hstepB, voffB);
            PG8_WAIT_V(6); PG8_BAR; PG8_MMA(1, 1, At, B1); PG8_BAR;
            }
        }
        if constexpr (ALIGN_EPI) { if (wr == 0) PG8_BAR; }
        if constexpr (!Epi::AFTER_DRAIN) { E(acc, cur, wr, wc, fr, fq); S.done(cur); }
        if (!has_next) break;
#pragma unroll
        for (int a = 0; a < 2; ++a)
#pragma unroll
            for (int b = 0; b < 2; ++b)
#pragma unroll
                for (int m = 0; m < 4; ++m)
#pragma unroll
                    for (int n = 0; n < 2; ++n) acc[a][b][m][n] = (f32x4){0.f, 0.f, 0.f, 0.f};
        cur = nxt; cA = nA; cB = nB; ++ui;
        if constexpr (ALIGN_EPI) { if (wr == 1) PG8_BAR; }
    }
    PG8_WAIT_V(0);
    if constexpr (!ALIGN_EPI) { if (wr == 0) PG8_BAR; }
    PG8_BAR;
    if constexpr (Epi::AFTER_DRAIN) { E.fused(acc, cur, wr, wc, fr, fq, lds, wid, lane); S.done(cur); }
#undef PG8_SA
#undef PG8_SB
#undef PG8_STAGE
#undef PG8_LDA
#undef PG8_LDB
#undef PG8_MMA
#undef PG8_WAIT_V
#undef PG8_WAIT_L
#undef PG8_BAR
#undef PG8_SCHED
}
}
#ifndef REP_INDEX
#define REP_INDEX 1
#endif
#ifndef REP_ATTN
#define REP_ATTN 1
#endif
#ifndef REP_DPREP
#define REP_DPREP 1
#endif
#ifndef REP_SCAN
#define REP_SCAN 1
#endif
#ifndef REP_RWIN
#define REP_RWIN 1
#endif
#define LAS __attribute__((address_space(3)))
typedef unsigned short bf16;
typedef float f32x4 __attribute__((ext_vector_type(4)));
typedef float f32x2 __attribute__((ext_vector_type(2)));
typedef float f32x16 __attribute__((ext_vector_type(16)));
typedef short bf16x8 __attribute__((ext_vector_type(8)));
typedef unsigned u32x4 __attribute__((ext_vector_type(4)));
typedef unsigned u32x2 __attribute__((ext_vector_type(2)));
typedef unsigned long long u64;

constexpr int D = 1024, NB = 8, SEQ = 4096, M = NB * SEQ, DFF = 2816, NMOD = 9 * D;
constexpr int DSA_N = 2304, DSA_NREAL = 2120;
constexpr int RW_N = 3584, RW_K = 2048, LORA_K = 384;
constexpr int LDS_BYTES = 147456;
constexpr int NTHREADS = 512;
constexpr size_t MiB = 1u << 20;
constexpr size_t WS_MOD = 0;
constexpr size_t WS_BAR = 768 * 1024;
constexpr int XB_LDS_OFF = 140000;
constexpr size_t WS_L1W = 1 * MiB;
constexpr size_t WS_WGU1 = WS_L1W;
constexpr size_t WS_WDN1 = WS_WGU1 + 22 * MiB;
constexpr size_t WS_WRWIN = WS_WDN1 + 11 * MiB;
constexpr size_t WS_WLORA = WS_WRWIN + 14 * MiB;
constexpr size_t WS_WRWOUT = WS_WLORA + 3 * MiB;
constexpr size_t WS_L0W = 53 * MiB;
constexpr size_t WS_WGU0 = WS_L0W;
constexpr size_t WS_WDN0 = WS_WGU0 + 22 * MiB;
constexpr size_t WS_WDSAIN = WS_WDN0 + 11 * MiB;
constexpr size_t WS_WDSAOUT = WS_WDSAIN + 5 * MiB;
constexpr size_t WS_U = 93 * MiB;
constexpr size_t WS_ACT = 157 * MiB;
constexpr size_t WS_QKVI = 157 * MiB;
constexpr size_t WS_QN = 301 * MiB;
constexpr size_t WS_KN = 365 * MiB;
constexpr size_t WS_VT = 381 * MiB;
constexpr size_t WS_IKN = 397 * MiB;
constexpr size_t WS_IW = 401 * MiB;
constexpr size_t WS_MASK = 402 * MiB;
constexpr size_t WS_A2 = 53 * MiB;
constexpr size_t WS_RK = 181 * MiB;
constexpr size_t WS_Y = 405 * MiB;
constexpr size_t WS_BIAS = 470 * MiB;
constexpr size_t WS_PART = 471 * MiB;
constexpr size_t WS_NEED = 473 * MiB;
constexpr int BV_GU0B = 0, BV_DSA = 8 * 5632, BV_GU1A = BV_DSA + 8 * 2304, BV_GU1B = BV_GU1A + 8 * 5632;

struct Args {
    const float* in[27];
    float* out; unsigned char* ws;
};
enum { I_X = 0, I_C, I_ADAW, I_ADAB, I_WGU, I_WDN, I_DSAIN, I_QNORM, I_KNORM, I_IKNORM, I_DSAOUT, I_MU, I_WRKV, I_W0, I_W1, I_W2, I_A0, I_A1, I_A2,
       I_G1, I_G2, I_KK, I_KA, I_RK, I_LNW, I_LNB, I_RWOUT };

__device__ __forceinline__ unsigned f2bf(float f) { unsigned u = __builtin_bit_cast(unsigned, f); return (u + 0x7fffu + ((u >> 16) & 1u)) >> 16; }
typedef __bf16 hwbf16x2 __attribute__((ext_vector_type(2)));
__device__ __forceinline__ unsigned pk2(float lo, float hi) { const f32x2 v = {lo, hi}; const hwbf16x2 b = __builtin_convertvector(v, hwbf16x2); return __builtin_bit_cast(unsigned, b); }
__device__ __forceinline__ float bf2f(unsigned short b) { return __builtin_bit_cast(float, (unsigned)b << 16); }
__device__ __forceinline__ float bflo(unsigned w) { return __builtin_bit_cast(float, w << 16); }
__device__ __forceinline__ float bfhi(unsigned w) { return __builtin_bit_cast(float, w & 0xffff0000u); }
__device__ __forceinline__ float wave_sum(float v) {
#pragma unroll
    for (int o = 1; o < 64; o <<= 1) v += __shfl_xor(v, o);
    return v;
}
template <int CTRL> __device__ __forceinline__ float dppf(float v) { return __builtin_bit_cast(float, __builtin_amdgcn_mov_dpp(__builtin_bit_cast(int, v), CTRL, 0xF, 0xF, true)); }
__device__ __forceinline__ float row16_sum(float v) {
    v += dppf<0xB1>(v);
    v += dppf<0x4E>(v);
    v += dppf<0x141>(v);
    v += dppf<0x140>(v);
    return v;
}
__device__ __forceinline__ float sigmoidf_(float x) { return __builtin_amdgcn_rcpf(1.f + __expf(-x)); }
__device__ __forceinline__ float siluf_(float x) { return x * sigmoidf_(x); }

struct XDesc { const float* W; int K, N, Npad; bf16* WT; int ldo, koff, rowoff, mode; const float* kscale; };
__device__ __forceinline__ void xpose_load(const XDesc& d, int tile, int tid, float (&v)[8]) {
    const int ntn = d.Npad / 64, kb = tile / ntn, nb = tile % ntn, k0 = kb * 64, n0 = nb * 64;
    const int nn = tid & 63, n = n0 + nn;
#pragma unroll
    for (int i = 0; i < 8; ++i) {
        const int kk = (tid >> 6) + 8 * i, k = k0 + kk;
        float x = (n < d.N) ? d.W[(size_t)k * d.N + n] : 0.f;
        if (d.kscale) x *= d.kscale[k];
        v[i] = x;
    }
}
__device__ __forceinline__ void xpose_lds(const float (&v)[8], float* scr, int tid) {
#pragma unroll
    for (int i = 0; i < 8; ++i) scr[((tid >> 6) + 8 * i) * 65 + (tid & 63)] = v[i];
}
__device__ __forceinline__ void xpose_write(const XDesc& d, int tile, const float* scr, int tid) {
    const int ntn = d.Npad / 64, kb = tile / ntn, nb = tile % ntn, k0 = kb * 64, n0 = nb * 64;
    const int nl = tid >> 3, kc = (tid & 7) * 8, n = n0 + nl;
    const int orow = d.rowoff + (d.mode == 1 ? ((n % DFF) * 2 + n / DFF) : n);
    const float* s = scr + kc * 65 + nl;
    u32x4 o; o.x = pk2(s[0], s[65]); o.y = pk2(s[2 * 65], s[3 * 65]); o.z = pk2(s[4 * 65], s[5 * 65]); o.w = pk2(s[6 * 65], s[7 * 65]);
    *(u32x4*)(d.WT + (size_t)orow * d.ldo + d.koff + k0 + kc) = o;
}
__device__ __forceinline__ int xd_tiles(int K, int Npad) { return (K / 64) * (Npad / 64); }

#define P0_DECODE(it_, d, r) do { r = (it_); d.mode = 0; d.kscale = nullptr; d.koff = 0; d.rowoff = 0;\
        if (r < 4 * T_GU) { const int w = r / T_GU; r -= w * T_GU; \
            d.W = a.in[I_WGU] + (size_t)w * D * 2 * DFF; d.K = D; d.N = 2 * DFF; d.Npad = 2 * DFF; d.ldo = D; d.mode = 1;\
            d.WT = (bf16*)(ws + (w < 2 ? WS_WGU0 + (size_t)w * 11 * MiB : WS_WGU1 + (size_t)(w - 2) * 11 * MiB));\
        } else if ((r -= 4 * T_GU) < 4 * T_DN) { const int w = r / T_DN; r -= w * T_DN;\
            d.W = a.in[I_WDN] + (size_t)w * DFF * D; d.K = DFF; d.N = D; d.Npad = D; d.ldo = DFF;\
            d.WT = (bf16*)(ws + (w < 2 ? WS_WDN0 + (size_t)w * 5767168 : WS_WDN1 + (size_t)(w - 2) * 5767168));\
        } else if ((r -= 4 * T_DN) < T_DIN) {\
            d.W = a.in[I_DSAIN]; d.K = D; d.N = DSA_NREAL; d.Npad = DSA_N; d.ldo = D; d.WT = (bf16*)(ws + WS_WDSAIN);\
        } else if ((r -= T_DIN) < T_SQ) {\
            d.W = a.in[I_DSAOUT]; d.K = D; d.N = D; d.Npad = D; d.ldo = D; d.WT = (bf16*)(ws + WS_WDSAOUT);\
        } else if ((r -= T_SQ) < 6 * T_SQ) { const int w = r / T_SQ; r -= w * T_SQ; const int i = w >> 1, sec = w & 1; \
            d.W = a.in[I_WRKV] + (size_t)i * D * D; d.K = D; d.N = D; d.Npad = D; d.ldo = RW_K; d.koff = sec * D; d.rowoff = i * D;\
            d.kscale = sec ? a.in[I_MU] + i * D : nullptr; d.WT = (bf16*)(ws + WS_WRWIN);\
        } else if ((r -= 6 * T_SQ) < 4 * T_L64) { const int w = r / T_L64; r -= w * T_L64; const int i = w >> 1, sec = w & 1; \
            d.W = a.in[i == 0 ? I_W1 : I_A1]; d.K = D; d.N = 64; d.Npad = 64; d.ldo = RW_K; d.koff = sec * D; d.rowoff = 3072 + 64 * i;\
            d.kscale = sec ? a.in[I_MU] + (3 + i) * D : nullptr; d.WT = (bf16*)(ws + WS_WRWIN);\
        } else if ((r -= 4 * T_L64) < 2 * T_G1) { const int sec = r / T_G1; r -= sec * T_G1;\
            d.W = a.in[I_G1]; d.K = D; d.N = 160; d.Npad = 384; d.ldo = RW_K; d.koff = sec * D; d.rowoff = 3200;\
            d.kscale = sec ? a.in[I_MU] + 5 * D : nullptr; d.WT = (bf16*)(ws + WS_WRWIN);\
        } else { r -= 2 * T_G1;\
            d.W = a.in[I_RWOUT]; d.K = D; d.N = D; d.Npad = D; d.ldo = D; d.WT = (bf16*)(ws + WS_WRWOUT);\
        } } while (0)
__device__ __forceinline__ void p0_prep(const Args& a, unsigned char* lds, int tid) {
    asm volatile("" : "+v"(tid));
    unsigned char* ws = a.ws;
    float* scr = (float*)lds;
    float* cs = (float*)(lds + 16640);
    float* red = (float*)(lds + 16640 + 32768);
    const int G = gridDim.x, bid = blockIdx.x;
    if (bid == 0) { unsigned* bw = (unsigned*)(ws + WS_BAR); for (int i = tid; i < 3456; i += NTHREADS) bw[i] = 0u; }
    constexpr int T_GU = 16 * 88, T_DN = 44 * 16, T_DIN = 16 * 36, T_SQ = 16 * 16, T_L64 = 16 * 1, T_G1 = 16 * 6;
    constexpr int NDESC = 4 + 4 + 1 + 1 + 6 + 2 + 2 + 2 + 1;
    int total = 4 * T_GU + 4 * T_DN + T_DIN + T_SQ + 6 * T_SQ + 4 * T_L64 + 2 * T_G1 + T_SQ;
    {
        XDesc d, dn; int r = 0, rn = 0; float v[8], vn[8];
        int it = bid;
        if (it < total) { P0_DECODE(it, d, r); xpose_load(d, r, tid, v); }
        while (it < total) {
            xpose_lds(v, scr, tid);
            __syncthreads();
            const int itn = it + G;
            if (itn < total) { P0_DECODE(itn, dn, rn); xpose_load(dn, rn, tid, vn); }
            xpose_write(d, r, scr, tid);
            __syncthreads();
            d = dn; r = rn; it = itn;
#pragma unroll
            for (int i = 0; i < 8; ++i) v[i] = vn[i];
        }
    }
    (void)NDESC;
    {
        bf16* WL = (bf16*)(ws + WS_WLORA);
        for (int idx = bid * NTHREADS + tid; idx < (LORA_K / 8) * 3072; idx += G * NTHREADS) {
            const int kg = idx / 3072, n = idx % 3072, blk = n >> 10, nn = n & 1023;
            float v[8];
#pragma unroll
            for (int j = 0; j < 8; ++j) { const int k = kg * 8 + j; float x = 0.f;
                if (blk == 0) { if (k < 64) x = a.in[I_W2][(size_t)k * D + nn]; }
                else if (blk == 1) { if (k >= 64 && k < 128) x = a.in[I_A2][(size_t)(k - 64) * D + nn]; }
                else { if (k >= 128 && k < 288) x = a.in[I_G2][(size_t)(k - 128) * D + nn]; }
                v[j] = x; }
            u32x4 o; o.x = pk2(v[0], v[1]); o.y = pk2(v[2], v[3]); o.z = pk2(v[4], v[5]); o.w = pk2(v[6], v[7]);
            *(u32x4*)(WL + (size_t)n * LORA_K + kg * 8) = o;
        }
    }
    if (bid < 288) {
        for (int i = tid; i < NB * D; i += NTHREADS) cs[i] = siluf_(a.in[I_C][i]);
        __syncthreads();
        const int lane = tid & 63, w = tid >> 6;
        float* MOD = (float*)(ws + WS_MOD);
        for (int tile = bid; tile < 288; tile += G) {
            const int l = tile / 144, n = (tile % 144) * 64 + lane;
            const float* wp = a.in[I_ADAW] + ((size_t)l * D + w * 128) * NMOD + n;
            float acc[8];
#pragma unroll
            for (int b = 0; b < 8; ++b) acc[b] = 0.f;
#pragma unroll 32
            for (int k = 0; k < 128; ++k) { const float wv = wp[(size_t)k * NMOD];
#pragma unroll
                for (int b = 0; b < 8; ++b) acc[b] += cs[b * D + w * 128 + k] * wv; }
#pragma unroll
            for (int b = 0; b < 8; ++b) red[(w * 8 + b) * 64 + lane] = acc[b];
            __syncthreads();
            { const int b = tid >> 6; float s = a.in[I_ADAB][l * NMOD + n];
#pragma unroll
              for (int ww = 0; ww < 8; ++ww) s += red[(ww * 8 + b) * 64 + lane];
              MOD[(size_t)(l * 8 + b) * NMOD + n] = s; }
            __syncthreads();
        }
    }
}

__device__ __forceinline__ void norm_row(const float* hrow, const float* sh, const float* sc, int lane, f32x4 (&u)[4]) {
    float ss = 0.f;
#pragma unroll
    for (int j = 0; j < 4; ++j) { u[j] = *(const f32x4*)(hrow + 4 * lane + 256 * j); ss += (u[j].x * u[j].x + u[j].y * u[j].y) + (u[j].z * u[j].z + u[j].w * u[j].w); }
    ss = wave_sum(ss);
    const float rstd = __builtin_amdgcn_rsqf(ss * (1.f / D) + 1e-6f);
#pragma unroll
    for (int j = 0; j < 4; ++j) { const f32x4 a = *(const f32x4*)(sc + 4 * lane + 256 * j), b = *(const f32x4*)(sh + 4 * lane + 256 * j);
        u[j] = (u[j] * rstd) * (a + 1.0f) + b; }
}
__device__ __forceinline__ void norm_phase(const float* h, const float* modl  , int idx  , bf16* U, int mode, int tid) {
    asm volatile("" : "+v"(tid));
    const int lane = tid & 63, gw = blockIdx.x * 8 + (tid >> 6), NGW = gridDim.x * 8;
    for (int row = gw; row < M; row += NGW) {
        const int b = row >> 12, t = row & (SEQ - 1);
        const float* sh = modl + (size_t)b * NMOD + (idx * 3) * D; const float* sc = sh + D;
        f32x4 u[4]; norm_row(h + (size_t)row * D, sh, sc, lane, u);
        if (mode == 0) {
#pragma unroll
            for (int j = 0; j < 4; ++j) { u32x2 o; o.x = pk2(u[j].x, u[j].y); o.y = pk2(u[j].z, u[j].w); *(u32x2*)(U + (size_t)row * D + 4 * lane + 256 * j) = o; }
        } else {
            f32x4 p[4];
            if (t > 0) norm_row(h + (size_t)(row - 1) * D, sh, sc, lane, p);
            else {
#pragma unroll
                for (int j = 0; j < 4; ++j) p[j] = (f32x4){0.f, 0.f, 0.f, 0.f};
            }
#pragma unroll
            for (int j = 0; j < 4; ++j) { u32x2 o; o.x = pk2(u[j].x, u[j].y); o.y = pk2(u[j].z, u[j].w); *(u32x2*)(U + (size_t)row * RW_K + 4 * lane + 256 * j) = o;
                const f32x4 x = p[j] - u[j]; u32x2 q; q.x = pk2(x.x, x.y); q.y = pk2(x.z, x.w); *(u32x2*)(U + (size_t)row * RW_K + D + 4 * lane + 256 * j) = q; }
        }
    }
}

__device__ __forceinline__ void bias_phase(unsigned char* ws, int tid) {
    asm volatile("" : "+v"(tid));
    const int lane = tid & 63, gw = blockIdx.x * 8 + (tid >> 6), NGW = gridDim.x * 8;
    const int r16 = lane & 15, kg = lane >> 4;
    const float* MOD = (const float*)(ws + WS_MOD); float* BV = (float*)(ws + WS_BIAS);
    for (int task = gw; task < 352 * 3 + 144; task += NGW) {
        int t = task; const bf16* Bt; const float* sh; float* dst; int N;
        if (t < 352) { Bt = (const bf16*)(ws + WS_WGU0 + 11 * MiB); sh = MOD + 6 * D; dst = BV + BV_GU0B; N = 5632; }
        else if ((t -= 352) < 144) { Bt = (const bf16*)(ws + WS_WDSAIN); sh = MOD + 3 * D; dst = BV + BV_DSA; N = 2304; }
        else if ((t -= 144) < 352) { Bt = (const bf16*)(ws + WS_WGU1); sh = MOD + (size_t)8 * NMOD; dst = BV + BV_GU1A; N = 5632; }
        else { t -= 352; Bt = (const bf16*)(ws + WS_WGU1 + 11 * MiB); sh = MOD + (size_t)8 * NMOD + 6 * D; dst = BV + BV_GU1B; N = 5632; }
        const int n0 = t * 16;
        const float* ap = sh + (size_t)(r16 & 7) * NMOD + 8 * kg;
        const bf16* bp = Bt + (size_t)(n0 + r16) * D + 8 * kg;
        f32x4 acc = (f32x4){0.f, 0.f, 0.f, 0.f};
#pragma unroll 8
        for (int s = 0; s < 32; ++s) {
            const f32x4 x0 = *(const f32x4*)(ap + 32 * s), x1 = *(const f32x4*)(ap + 32 * s + 4);
            u32x4 aw; aw.x = pk2(x0.x, x0.y); aw.y = pk2(x0.z, x0.w); aw.z = pk2(x1.x, x1.y); aw.w = pk2(x1.z, x1.w);
            if (r16 >= 8) aw = (u32x4){0u, 0u, 0u, 0u};
            const bf16x8 bw = *(const bf16x8*)(bp + 32 * s);
            acc = __builtin_amdgcn_mfma_f32_16x16x32_bf16(__builtin_bit_cast(bf16x8, aw), bw, acc, 0, 0, 0);
        }
        if (kg < 2) {
#pragma unroll
            for (int v = 0; v < 4; ++v) dst[(size_t)(4 * kg + v) * N + n0 + r16] = acc[v];
        }
    }
}

namespace pg8 {
template <bool FOLD> struct EpiSwiglu {
    static constexpr bool PERM = true, AFTER_DRAIN = false;
    bf16_t* O; int ldc; const float* part; const float* biasv  ;
    __device__ __forceinline__ void operator()(const f32x4 (&acc)[2][2][4][2], const Unit& u, int wr, int wc, int fr, int fq) const {
        const int row0 = u.pm * BM + wr * 64 + fr, col0 = u.pn * BM + wc * 32 + 8 * fq;
        f32x4 bv[2][2];
        if (FOLD) { const float* bp = biasv + (size_t)(u.pm >> 4) * (2 * DFF) + col0;
#pragma unroll
            for (int bj = 0; bj < 2; ++bj) { bv[bj][0] = *(const f32x4*)(bp + bj * HALF); bv[bj][1] = *(const f32x4*)(bp + bj * HALF + 4); } }
        float rs[8];
        if (FOLD) {
#pragma unroll
            for (int i = 0; i < 8; ++i) { const f32x4 t = *(const f32x4*)(part + (size_t)(row0 + (i >> 2) * HALF + (i & 3) * 16) * 16 + 4 * fq); rs[i] = (t.x + t.y) + (t.z + t.w); }
#pragma unroll
            for (int i = 0; i < 8; ++i) { float t = rs[i]; t += __shfl_xor(t, 16); t += __shfl_xor(t, 32); rs[i] = __builtin_amdgcn_rsqf(t * (1.f / 1024.f) + 1e-6f); }
        }
#pragma unroll
        for (int ai = 0; ai < 2; ++ai)
#pragma unroll
            for (int m = 0; m < 4; ++m) { const int row = row0 + ai * HALF + m * 16; bf16_t* rowp = O + (size_t)row * ldc;
                const float rstd = FOLD ? rs[ai * 4 + m] : 1.f;
#pragma unroll
                for (int bj = 0; bj < 2; ++bj) { f32x4 v0 = acc[ai][bj][m][0], v1 = acc[ai][bj][m][1];
                    if (FOLD) { v0 = v0 * rstd + bv[bj][0]; v1 = v1 * rstd + bv[bj][1]; }
                    const float o0 = siluf_(v0[0]) * v0[1], o1 = siluf_(v0[2]) * v0[3], o2 = siluf_(v1[0]) * v1[1], o3 = siluf_(v1[2]) * v1[3];
                    u32x2 w; w.x = cvt_pk_bf16(o0, o1); w.y = cvt_pk_bf16(o2, o3);
                    *(u32x2*)(rowp + ((col0 + bj * HALF) >> 1)) = w; } }
    }
};
template <bool FOLD, bool HALFSC> struct EpiResid {
    static constexpr bool PERM = false, AFTER_DRAIN = false;
    const float* base; float* out; const float* gate  ;
    bf16_t* U2; const float* scn  ; float* part;
    __device__ __forceinline__ void operator()(const f32x4 (&acc)[2][2][4][2], const Unit& u, int wr, int wc, int fr, int fq) const {
        const int row0 = u.pm * BM + wr * 64 + fr, col0 = u.pn * BM + wc * 32 + 4 * fq;
        const float* gp = gate + (size_t)(u.pm >> 4) * NMOD;
        f32x4 gv[2][2], sv[2][2];
#pragma unroll
        for (int bj = 0; bj < 2; ++bj)
#pragma unroll
            for (int n = 0; n < 2; ++n) { gv[bj][n] = *(const f32x4*)(gp + col0 + bj * HALF + n * 16) * (HALFSC ? 0.5f : 1.0f);
                if (FOLD) sv[bj][n] = *(const f32x4*)(scn + (size_t)(u.pm >> 4) * NMOD + col0 + bj * HALF + n * 16) + 1.0f; }
#pragma unroll
        for (int ai = 0; ai < 2; ++ai)
#pragma unroll
            for (int m = 0; m < 4; ++m) { const int row = row0 + ai * HALF + m * 16; const size_t off = (size_t)row * D + col0;
                float ssq = 0.f;
#pragma unroll
                for (int bj = 0; bj < 2; ++bj)
#pragma unroll
                    for (int n = 0; n < 2; ++n) { const f32x4 bs = *(const f32x4*)(base + off + bj * HALF + n * 16);
                        const f32x4 o = bs + gv[bj][n] * acc[ai][bj][m][n];
                        *(f32x4*)(out + off + bj * HALF + n * 16) = o;
                        if (FOLD) { ssq += (o.x * o.x + o.y * o.y) + (o.z * o.z + o.w * o.w); const f32x4 q = o * sv[bj][n];
                            u32x2 w; w.x = cvt_pk_bf16(q.x, q.y); w.y = cvt_pk_bf16(q.z, q.w); *(u32x2*)(U2 + off + bj * HALF + n * 16) = w; } }
                if (FOLD) { ssq += __shfl_xor(ssq, 16); ssq += __shfl_xor(ssq, 32);
                    if (fq == 0) part[(size_t)row * 16 + (u.pn & 3) * 4 + wc] = ssq; } }
    }
};
template <int MODE> struct EpiBf16 {
    static constexpr bool PERM = true, AFTER_DRAIN = false;
    bf16_t* O; int ldc; const float* p0; const float* p1;
    __device__ __forceinline__ void operator()(const f32x4 (&acc)[2][2][4][2], const Unit& u, int wr, int wc, int fr, int fq) const {
        const int row0 = u.pm * BM + wr * 64 + fr, col0 = u.pn * BM + wc * 32 + 8 * fq;
        float rs[8];
        if (MODE == 3) {
#pragma unroll
            for (int i = 0; i < 8; ++i) { const f32x4 t = *(const f32x4*)(p0 + (size_t)(row0 + (i >> 2) * HALF + (i & 3) * 16) * 16 + 4 * fq); rs[i] = (t.x + t.y) + (t.z + t.w); }
#pragma unroll
            for (int i = 0; i < 8; ++i) { float t = rs[i]; t += __shfl_xor(t, 16); t += __shfl_xor(t, 32); rs[i] = __builtin_amdgcn_rsqf(t * (1.f / 1024.f) + 1e-6f); }
        }
#pragma unroll
        for (int bj = 0; bj < 2; ++bj) {
            const int c = col0 + bj * HALF;
            f32x4 b0 = (f32x4){0.f, 0.f, 0.f, 0.f}, b1 = b0; int kind = 0;
            if (MODE == 1) { kind = (c >= 3072 && c < 3136) ? 1 : ((c >= 3200) ? 2 : 0); }
            if (MODE == 3) { b0 = *(const f32x4*)(p1 + (size_t)(u.pm >> 4) * ldc + c); b1 = *(const f32x4*)(p1 + (size_t)(u.pm >> 4) * ldc + c + 4); }
            if (MODE == 2) { if (c < 1024) { kind = 3; b0 = *(const f32x4*)(p0 + c); b1 = *(const f32x4*)(p0 + c + 4); } else { kind = 2; b0 = *(const f32x4*)(p1 + c - 1024); b1 = *(const f32x4*)(p1 + c - 1024 + 4); } }
#pragma unroll
            for (int ai = 0; ai < 2; ++ai)
#pragma unroll
                for (int m = 0; m < 4; ++m) { bf16_t* rowp = O + (size_t)(row0 + ai * HALF + m * 16) * ldc + c;
                    f32x4 v0, v1;
                    if (MODE == 3) { const float rstd = rs[ai * 4 + m]; v0 = acc[ai][bj][m][0] * rstd + b0; v1 = acc[ai][bj][m][1] * rstd + b1; }
                    else { v0 = acc[ai][bj][m][0] + b0; v1 = acc[ai][bj][m][1] + b1; }
                    if (MODE == 1 || MODE == 2) {
#pragma unroll
                        for (int e = 0; e < 4; ++e) {
                            if (kind == 1) { v0[e] = 2.f * sigmoidf_(2.f * v0[e]) - 1.f; v1[e] = 2.f * sigmoidf_(2.f * v1[e]) - 1.f; }
                            else if (kind == 2) { v0[e] = sigmoidf_(v0[e]); v1[e] = sigmoidf_(v1[e]); }
                            else if (kind == 3) { v0[e] = 0.60653066f * sigmoidf_(v0[e]); v1[e] = 0.60653066f * sigmoidf_(v1[e]); }
                        }
                    }
                    u32x4 w; w.x = cvt_pk_bf16(v0[0], v0[1]); w.y = cvt_pk_bf16(v0[2], v0[3]); w.z = cvt_pk_bf16(v1[0], v1[1]); w.w = cvt_pk_bf16(v1[2], v1[3]);
                    *(u32x4*)rowp = w; }
        }
    }
};
}

template <bool ALIGN = true, class Epi> __device__ __forceinline__ void run_gemm(unsigned char* lds, const bf16* A, int lda, const bf16* Bt, int Mrows, int N, int K, const Epi& E) {
    asm volatile("" : "+s"(A), "+s"(Bt), "+s"(K));
    pg8::Gemm g{A, Bt, Mrows, N, K, lda}; pg8::StaticOrder S; S.init(Mrows, N, (int)gridDim.x, (int)blockIdx.x);
    pg8::gemm_phase<Epi, pg8::StaticOrder, ALIGN, true>((PG8_LAS unsigned char*)lds, g, S, E);
}
#define XB_TMO      128
#define XB_XCNT(j)  (256  + 64 * (j))
#define XB_XSUB(j)  (1280 + 64 * (j))
#define XB_XGEN(j)  (2304 + 64 * (j))
#define XB_TOP      3328
#define XB_TOPGEN   3392
#define XCD_BAR_WORDS 3456
#define XB_SPIN_CAP (1u << 18)

__device__ __forceinline__ unsigned xb_ld(unsigned* p)              { return __hip_atomic_load(p, __ATOMIC_RELAXED, __HIP_MEMORY_SCOPE_AGENT); }
__device__ __forceinline__ unsigned xb_add(unsigned* p, unsigned v) { return __hip_atomic_fetch_add(p, v, __ATOMIC_RELAXED, __HIP_MEMORY_SCOPE_AGENT); }
__device__ __forceinline__ unsigned xb_xcc_id() { return (unsigned)__builtin_amdgcn_s_getreg((3 << 11) | 20) & 0xFu; }
#define XB_SPIN(cond, bar) do { unsigned _sp = 0; while (cond) { __builtin_amdgcn_s_sleep(1); \
    if ((++_sp & 255u) == 0u) { if (xb_ld(&(bar)[XB_TMO])) break; if (_sp > XB_SPIN_CAP) { atomicAdd(&(bar)[XB_TMO], 1u); break; } } } } while (0)

struct XcdBarrier {
    unsigned* bar; unsigned x;
    volatile LAS unsigned* st;
};

__device__ __forceinline__ XcdBarrier xcd_barrier_post(unsigned* bar, volatile LAS unsigned* st) {
    XcdBarrier b; b.bar = bar; b.x = xb_xcc_id(); b.st = st;
    if (threadIdx.x == 0) (void)xb_add(&bar[XB_XCNT(b.x)], 1u);
    return b;
}
__device__ __forceinline__ void xcd_barrier_complete(unsigned* bar, unsigned x, unsigned& nloc, unsigned& nx) {
    const unsigned G = gridDim.x * gridDim.y * gridDim.z;
    unsigned sum, cnt, mine, sp = 0u;
    for (;;) {
        sum = 0u; cnt = 0u; mine = 0u;
#pragma unroll
        for (unsigned j = 0; j < 16; ++j) { const unsigned c = xb_ld(&bar[XB_XCNT(j)]); sum += c; cnt += (c > 0u) ? 1u : 0u; mine = (j == x) ? c : mine; }
        if (sum == G) break;
        __builtin_amdgcn_s_sleep(1);
        if ((++sp & 255u) == 0u) { if (xb_ld(&bar[XB_TMO])) break; if (sp > XB_SPIN_CAP) { atomicAdd(&bar[XB_TMO], 1u); break; } }
    }
    nloc = mine > 0u ? mine : 1u; nx = cnt > 0u ? cnt : 1u;
}

__device__ __forceinline__ void xcd_barrier(const XcdBarrier& b) {
    asm volatile("s_waitcnt vmcnt(0)" ::: "memory");
    __syncthreads();
    if (threadIdx.x == 0) {
        unsigned* bar = b.bar;
        __builtin_amdgcn_s_waitcnt(0);
        unsigned nloc = b.st[0], nx = b.st[1];
        if (nloc == 0u) { xcd_barrier_complete(bar, b.x, nloc, nx); b.st[0] = nloc; b.st[1] = nx; }
        const unsigned old = xb_add(&bar[XB_XSUB(b.x)], 1u);
        const unsigned gen = old / nloc;
        if (old + 1u == (gen + 1u) * nloc) {
            __builtin_amdgcn_fence(__ATOMIC_RELEASE, "agent");
            asm volatile("s_waitcnt vmcnt(0)" ::: "memory");
            const unsigned og = xb_add(&bar[XB_TOP], 1u);
            const unsigned tg = og / nx;
            if (og + 1u == (tg + 1u) * nx) xb_add(&bar[XB_TOPGEN], 1u);
            else XB_SPIN(xb_ld(&bar[XB_TOPGEN]) == tg, bar);
            __builtin_amdgcn_fence(__ATOMIC_ACQUIRE, "agent");
            xb_add(&bar[XB_XGEN(b.x)], 1u);
            asm volatile("s_waitcnt vmcnt(0)" ::: "memory");
        } else {
            XB_SPIN(xb_ld(&bar[XB_XGEN(b.x)]) == gen, bar);
            __builtin_amdgcn_fence(__ATOMIC_ACQUIRE, "agent");
            asm volatile("s_waitcnt vmcnt(0)" ::: "memory");
        }
    }
    __syncthreads();
}

constexpr int QKVI_LD = DSA_N;
constexpr float QSCALE = 0.18033688011112042f;
constexpr float IWSCALE = 0.04419417382415922f;

__device__ __forceinline__ void dsa_prep(const Args& a, unsigned char* lds, int tid) {
    asm volatile("" : "+v"(tid));
    unsigned char* ws = a.ws;
    const bf16* QKVI = (const bf16*)(ws + WS_QKVI);
    bf16* QN = (bf16*)(ws + WS_QN); bf16* KN = (bf16*)(ws + WS_KN); bf16* VT = (bf16*)(ws + WS_VT); bf16* IKN = (bf16*)(ws + WS_IKN); float* IW = (float*)(ws + WS_IW);
    bf16* vt = (bf16*)lds;
    const int lane = tid & 63, w = tid >> 6, sub = lane & 15, grp = lane >> 4;
    const f32x4 qn = *(const f32x4*)(a.in[I_QNORM] + 4 * sub), kn = *(const f32x4*)(a.in[I_KNORM] + 4 * sub), ikn = *(const f32x4*)(a.in[I_IKNORM] + 4 * sub);
    for (int blk = blockIdx.x; blk < M / 64; blk += gridDim.x) {
        const int t0 = blk * 64, b = t0 >> 12, tt0 = t0 & (SEQ - 1);
#pragma unroll 4
        for (int i = 0; i < 8; ++i) {
            const int row = t0 + 8 * w + i;
            const bf16* src = QKVI + (size_t)row * QKVI_LD;
#pragma unroll
            for (int j = 0; j < 5; ++j) {
                const int hh = j * 4 + grp, col = hh * 64 + 4 * sub;
                const u32x2 x = *(const u32x2*)(src + col);
                f32x4 v = (f32x4){bflo(x.x), bfhi(x.x), bflo(x.y), bfhi(x.y)};
                float ss = (v.x * v.x + v.y * v.y) + (v.z * v.z + v.w * v.w);
                ss = row16_sum(ss);
                const float rstd = __builtin_amdgcn_rsqf(ss * (1.f / 64.f) + 1e-6f);
                if (j < 4) { v = v * rstd * qn * QSCALE; u32x2 o; o.x = pk2(v.x, v.y); o.y = pk2(v.z, v.w); *(u32x2*)(QN + (size_t)row * D + col) = o; }
                else { v = v * rstd * kn; u32x2 o; o.x = pk2(v.x, v.y); o.y = pk2(v.z, v.w); *(u32x2*)(KN + (size_t)row * 256 + (col - 1024)) = o; }
            }
            {
                const u32x2 x = *(const u32x2*)(src + 2048 + 4 * sub);
                f32x4 v = (f32x4){bflo(x.x), bfhi(x.x), bflo(x.y), bfhi(x.y)};
                float ss = (v.x * v.x + v.y * v.y) + (v.z * v.z + v.w * v.w);
                ss = row16_sum(ss);
                const float rstd = __builtin_amdgcn_rsqf(ss * (1.f / 64.f) + 1e-6f);
                v = v * rstd * ikn;
                if (grp == 0) { u32x2 o; o.x = pk2(v.x, v.y); o.y = pk2(v.z, v.w); *(u32x2*)(IKN + (size_t)row * 64 + 4 * sub) = o; }
                if (lane < 8) IW[(size_t)row * 8 + lane] = bf2f(src[2112 + lane]) * IWSCALE;
            }
        }
        for (int task = tid; task < 64 * 64; task += NTHREADS) {
            const int tok = task >> 6, c4 = task & 63;
            const u32x2 x = *(const u32x2*)(QKVI + (size_t)(t0 + tok) * QKVI_LD + 1280 + 4 * c4);
            vt[(4 * c4 + 0) * 72 + tok] = (bf16)(x.x & 0xffffu); vt[(4 * c4 + 1) * 72 + tok] = (bf16)(x.x >> 16);
            vt[(4 * c4 + 2) * 72 + tok] = (bf16)(x.y & 0xffffu); vt[(4 * c4 + 3) * 72 + tok] = (bf16)(x.y >> 16);
        }
        __syncthreads();
        {
            const int col = tid >> 1, half = tid & 1;
            bf16* dst = VT + ((size_t)(b * 4 + (col >> 6)) * 64 + (col & 63)) * SEQ + tt0 + half * 32;
#pragma unroll
            for (int i = 0; i < 4; ++i) *(u32x4*)(dst + 8 * i) = *(const u32x4*)(vt + col * 72 + half * 32 + 8 * i);
        }
        __syncthreads();
    }
}

__device__ __forceinline__ u64 cmp_ge_mask(unsigned v, unsigned c) { u64 m; asm("v_cmp_ge_u32_e64 %0, %1, %2" : "=s"(m) : "v"(v), "s"(c)); return m; }
__device__ __forceinline__ unsigned f2key(float f) { const unsigned u = __builtin_bit_cast(unsigned, f); return (u & 0x80000000u) ? ~u : (u | 0x80000000u); }

template <bool DO_SELECT> __device__ __forceinline__ void dsa_index(const Args& a, unsigned char* lds, int tid) {
    asm volatile("" : "+v"(tid));
    unsigned char* ws = a.ws;
    const bf16* QKVI = (const bf16*)(ws + WS_QKVI); const bf16* IKN = (const bf16*)(ws + WS_IKN); const float* IW = (const float*)(ws + WS_IW);
    u64* MASK = (u64*)(ws + WS_MASK);
    float* scl = (float*)lds;
    const int lane = tid & 63, w = __builtin_amdgcn_readfirstlane(tid >> 6), hi = lane >> 5, l32 = lane & 31;
    const int G = gridDim.x;
    for (int r = blockIdx.x; r < M / 8; r += G) {
        const int b = r >> 9; int qi = r & 511; if ((r >> 9) & 1) qi = 511 - qi;
        const int q0 = qi * 8, nch = (q0 >> 6) + 1;
        const size_t rowb = (size_t)b * SEQ;
        const int a_ql = 2 * ((l32 >> 2) & 1) + (l32 >> 4), a_h = ((l32 >> 3) & 1) * 4 + (l32 & 3);
        bf16x8 af[2][4];
#pragma unroll
        for (int rb = 0; rb < 2; ++rb)
#pragma unroll
            for (int ks = 0; ks < 4; ++ks)
                af[rb][ks] = *(const bf16x8*)(QKVI + (rowb + q0 + rb * 4 + a_ql) * QKVI_LD + 1536 + a_h * 64 + 16 * ks + 8 * hi);
        f32x4 iwv[2][2][2];
#pragma unroll
        for (int rb = 0; rb < 2; ++rb)
#pragma unroll
            for (int jj = 0; jj < 2; ++jj) { const float* ip = IW + (rowb + q0 + rb * 4 + 2 * hi + jj) * 8; iwv[rb][jj][0] = *(const f32x4*)ip; iwv[rb][jj][1] = *(const f32x4*)(ip + 4); }
        for (int ch = w; ch < nch; ch += 8) {
#pragma unroll
            for (int cb = 0; cb < 2; ++cb) {
                bf16x8 bfr[4];
#pragma unroll
                for (int ks = 0; ks < 4; ++ks) bfr[ks] = *(const bf16x8*)(IKN + (rowb + ch * 64 + cb * 32 + l32) * 64 + 16 * ks + 8 * hi);
                const int key = ch * 64 + cb * 32 + l32;
#pragma unroll
                for (int rb = 0; rb < 2; ++rb) {
                    f32x16 acc;
#pragma unroll
                    for (int e = 0; e < 16; ++e) acc[e] = 0.f;
#pragma unroll
                    for (int ks = 0; ks < 4; ++ks) acc = __builtin_amdgcn_mfma_f32_32x32x16_bf16(af[rb][ks], bfr[ks], acc, 0, 0, 0);
#pragma unroll
                    for (int jj = 0; jj < 2; ++jj) {
                        float sc = 0.f;
#pragma unroll
                        for (int e = 0; e < 8; ++e) sc = fmaf(fmaxf(acc[8 * jj + e], 0.f), iwv[rb][jj][e >> 2][e & 3], sc);
                        const int q = rb * 4 + 2 * hi + jj;
                        if (key > q0 + q) sc = -INFINITY;
                        scl[q * SEQ + key] = sc;
                    }
                }
            }
        }
        __syncthreads();
        if (DO_SELECT) {
            const int q = q0 + w, nreg = (q >> 6) + 1;
            unsigned u[64];
#pragma unroll
            for (int i = 0; i < 64; ++i) {
                unsigned v = 0u;
                if (i < nreg) { const int key = i * 64 + lane; const float f = scl[w * SEQ + key]; v = (key <= q) ? f2key(f) : 0u; }
                u[i] = v;
            }
            u64 myword = 0ull;
            if (q + 1 <= 256) {
#pragma unroll
                for (int i = 0; i < 64; ++i) { const u64 wd = __ballot(i * 64 + lane <= q); if (lane == i) myword = wd; }
            } else {
                unsigned prefix = 0u, ecand = 0u; bool exact = false;
                for (int bit = 31; bit >= 0; --bit) {
                    const unsigned cand = prefix | (1u << bit);
                    int cnt = 0;
#pragma unroll
                    for (int g = 0; g < 8; ++g) {
                        if (g * 8 < nreg) {
                            u64 m0, m1, m2, m3, m4, m5, m6, m7;
                            asm("v_cmp_ge_u32_e64 %0, %8, %16\n\tv_cmp_ge_u32_e64 %1, %9, %16\n\tv_cmp_ge_u32_e64 %2, %10, %16\n\tv_cmp_ge_u32_e64 %3, %11, %16\n\t"
                                "v_cmp_ge_u32_e64 %4, %12, %16\n\tv_cmp_ge_u32_e64 %5, %13, %16\n\tv_cmp_ge_u32_e64 %6, %14, %16\n\tv_cmp_ge_u32_e64 %7, %15, %16"
                                : "=&s"(m0), "=&s"(m1), "=&s"(m2), "=&s"(m3), "=&s"(m4), "=&s"(m5), "=&s"(m6), "=&s"(m7)
                                : "v"(u[g * 8 + 0]), "v"(u[g * 8 + 1]), "v"(u[g * 8 + 2]), "v"(u[g * 8 + 3]), "v"(u[g * 8 + 4]), "v"(u[g * 8 + 5]), "v"(u[g * 8 + 6]), "v"(u[g * 8 + 7]), "s"(cand));
                            cnt += (__builtin_popcountll(m0) + __builtin_popcountll(m1)) + (__builtin_popcountll(m2) + __builtin_popcountll(m3))
                                 + (__builtin_popcountll(m4) + __builtin_popcountll(m5)) + (__builtin_popcountll(m6) + __builtin_popcountll(m7));
                        }
                    }
                    if (cnt == 256) { exact = true; ecand = cand; break; }
                    if (cnt > 256) prefix = cand;
                }
                if (exact) {
#pragma unroll
                    for (int i = 0; i < 64; ++i) { const u64 wd = __ballot(u[i] >= ecand); if (lane == i) myword = wd; }
                } else {
                    const unsigned T = prefix;
                    int ngt = 0;
#pragma unroll
                    for (int i = 0; i < 64; ++i) ngt += __builtin_popcountll(__ballot(u[i] > T));
                    int need = 256 - ngt;
#pragma unroll
                    for (int i = 0; i < 64; ++i) {
                        const u64 gt = __ballot(u[i] > T); u64 eq = __ballot(u[i] == T);
                        while (__builtin_popcountll(eq) > need) eq &= ~(1ull << (63 - __builtin_clzll(eq)));
                        need -= __builtin_popcountll(eq);
                        const u64 wd = gt | eq; if (lane == i) myword = wd;
                    }
                }
            }
            MASK[(rowb + q) * 64 + lane] = myword;
        }
        __syncthreads();
    }
}

template <int PV> __device__ __forceinline__ void dsa_attn(const Args& a, unsigned char* lds, int tid) {
    asm volatile("" : "+v"(tid));
    unsigned char* ws = a.ws;
    const bf16* QN = (const bf16*)(ws + WS_QN); const bf16* KN = (const bf16*)(ws + WS_KN); const bf16* VT = (const bf16*)(ws + WS_VT);
    const u64* MASK = (const u64*)(ws + WS_MASK);
    bf16* O = (bf16*)(ws + (PV == 0 ? WS_QN : WS_U));
    bf16* ksm = (bf16*)lds;
    bf16* vsm = (bf16*)(lds + 4 * 64 * 72 * 2);
    const int lane = tid & 63, w = __builtin_amdgcn_readfirstlane(tid >> 6), hi = lane >> 5, l32 = lane & 31;
    const int srow = tid >> 3, sc16 = tid & 7;
    float nB;
    { float mq = fabsf(a.in[I_QNORM][lane]), mk = fabsf(a.in[I_KNORM][lane]);
#pragma unroll
      for (int o = 1; o < 64; o <<= 1) { mq = fmaxf(mq, __shfl_xor(mq, o)); mk = fmaxf(mk, __shfl_xor(mk, o)); }
      nB = -(64.0f * QSCALE * 1.02f) * mq * mk; }
    for (int c = blockIdx.x; c < 256; c += gridDim.x)
    for (int k = 0; k < 8; ++k) {
        const int vc = (gridDim.x == 256) ? ((c & 7) * 32 + (c >> 3)) : c;
        const int bg = (vc >> 6) + 4 * k, b = bg >> 2, g = bg & 3;
        int qt = vc & 63; if (k & 1) qt = 63 - qt;
        const int hq = g * 4 + (w & 3), qb = qt * 64 + (w >> 2) * 32 + l32;
        const size_t rowb = (size_t)b * SEQ;
        const int ntile = qt + 1;
        bf16x8 qf[4];
#pragma unroll
        for (int ks = 0; ks < 4; ++ks) qf[ks] = *(const bf16x8*)(QN + (rowb + qb) * D + hq * 64 + 16 * ks + 8 * hi);
        const bf16* kg = KN + (rowb + srow) * 256 + g * 64 + sc16 * 8;
        const bf16* vg = VT + ((size_t)(b * 4 + g) * 64 + srow) * SEQ + sc16 * 8;
        const u64* mrow = MASK + (rowb + qb) * 64;
        u32x4 kr0 = *(const u32x4*)kg, vr0 = *(const u32x4*)vg, kr1 = kr0, vr1 = vr0;
        if (ntile > 1) { kr1 = *(const u32x4*)(kg + (size_t)64 * 256); vr1 = *(const u32x4*)(vg + 64); }
        *(u32x4*)(ksm + srow * 72 + sc16 * 8) = kr0; *(u32x4*)(vsm + srow * 72 + sc16 * 8) = vr0;
        *(u32x4*)(ksm + 64 * 72 + srow * 72 + sc16 * 8) = kr1; *(u32x4*)(vsm + 64 * 72 + srow * 72 + sc16 * 8) = vr1;
        __syncthreads();
        f32x16 o0, o1;
#pragma unroll
        for (int e = 0; e < 16; ++e) { o0[e] = 0.f; o1[e] = 0.f; }
        float lsum = 0.f;
        u64 mwa = mrow[0], mwb = (ntile > 1) ? mrow[1] : 0ull;
#define ATT_QK(KB_, P0, P1) do { const bf16* kb_ = (KB_); \
            _Pragma("unroll") for (int e = 0; e < 16; ++e) { P0[e] = nB; P1[e] = nB; } \
            if (PV != 4) _Pragma("unroll") for (int ks = 0; ks < 4; ++ks) { \
                const bf16x8 ka = *(const bf16x8*)(kb_ + l32 * 72 + 16 * ks + 8 * hi); \
                const bf16x8 kc = *(const bf16x8*)(kb_ + (32 + l32) * 72 + 16 * ks + 8 * hi); \
                P0 = __builtin_amdgcn_mfma_f32_32x32x16_bf16(ka, qf[ks], P0, 0, 0, 0); \
                P1 = __builtin_amdgcn_mfma_f32_32x32x16_bf16(kc, qf[ks], P1, 0, 0, 0); } } while (0)
#define ATT_SM(MW_, P0, P1) do { const u64 mw = (MW_); \
            const unsigned m0 = (unsigned)mw >> (4 * hi), m1 = (unsigned)(mw >> 32) >> (4 * hi); \
            float ps = 0.f, ps2 = 0.f; \
            if (PV != 2) _Pragma("unroll") for (int v = 0; v < 16; ++v) { \
                const int cbit = 8 * (v >> 2) + (v & 3); \
                int t0, t1; asm("v_bfe_i32 %0, %1, %2, 1" : "=v"(t0) : "v"(m0), "n"(cbit)); asm("v_bfe_i32 %0, %1, %2, 1" : "=v"(t1) : "v"(m1), "n"(cbit)); \
                P0[v] = __builtin_bit_cast(float, __builtin_bit_cast(int, __builtin_amdgcn_exp2f(P0[v])) & t0); \
                P1[v] = __builtin_bit_cast(float, __builtin_bit_cast(int, __builtin_amdgcn_exp2f(P1[v])) & t1); \
                asm("v_add_f32 %0, %1, %0" : "+v"(ps) : "v"(P0[v])); asm("v_add_f32 %0, %1, %0" : "+v"(ps2) : "v"(P1[v])); } \
            lsum += ps + ps2; } while (0)
#define ATT_PV(VB_, P0, P1) do { const bf16* vb_ = (VB_); \
            if (PV == 3) { lsum += P0[0] + P1[5]; } else \
            _Pragma("unroll") for (int kb = 0; kb < 2; ++kb) \
            _Pragma("unroll") for (int s = 0; s < 2; ++s) { \
                    u32x4 pb; \
                    if (kb == 0) { pb.x = pk2(P0[8 * s + 0], P0[8 * s + 1]); pb.y = pk2(P0[8 * s + 2], P0[8 * s + 3]); pb.z = pk2(P0[8 * s + 4], P0[8 * s + 5]); pb.w = pk2(P0[8 * s + 6], P0[8 * s + 7]); } \
                    else         { pb.x = pk2(P1[8 * s + 0], P1[8 * s + 1]); pb.y = pk2(P1[8 * s + 2], P1[8 * s + 3]); pb.z = pk2(P1[8 * s + 4], P1[8 * s + 5]); pb.w = pk2(P1[8 * s + 6], P1[8 * s + 7]); } \
                    const bf16x8 pbv = __builtin_bit_cast(bf16x8, pb); \
                    const int base = kb * 32 + 16 * s + 4 * hi; \
                    { const u32x2 lo = *(const u32x2*)(vb_ + l32 * 72 + base), hi2 = *(const u32x2*)(vb_ + l32 * 72 + base + 8); \
                      const u32x4 va = (u32x4){lo.x, lo.y, hi2.x, hi2.y}; \
                      o0 = __builtin_amdgcn_mfma_f32_32x32x16_bf16(__builtin_bit_cast(bf16x8, va), pbv, o0, 0, 0, 0); } \
                    { const u32x2 lo = *(const u32x2*)(vb_ + (32 + l32) * 72 + base), hi2 = *(const u32x2*)(vb_ + (32 + l32) * 72 + base + 8); \
                      const u32x4 va = (u32x4){lo.x, lo.y, hi2.x, hi2.y}; \
                      o1 = __builtin_amdgcn_mfma_f32_32x32x16_bf16(__builtin_bit_cast(bf16x8, va), pbv, o1, 0, 0, 0); } } \
        } while (0)
        for (int j = 0; j < ntile; j += 2) {
            const int set = (j >> 1) & 1;
            const bool have2 = (j + 1 < ntile), more0 = (j + 2 < ntile), more1 = (j + 3 < ntile);
            if (more0) { kr0 = *(const u32x4*)(kg + (size_t)(j + 2) * 64 * 256); vr0 = *(const u32x4*)(vg + (j + 2) * 64); }
            if (more1) { kr1 = *(const u32x4*)(kg + (size_t)(j + 3) * 64 * 256); vr1 = *(const u32x4*)(vg + (j + 3) * 64); }
            const u64 mw0 = mwa, mw1 = mwb;
            if (more0) mwa = mrow[j + 2];
            if (more1) mwb = mrow[j + 3];
            const bf16* kA = ksm + (2 * set) * 64 * 72; const bf16* vA = vsm + (2 * set) * 64 * 72;
            const bf16* kB = kA + 64 * 72; const bf16* vB = vA + 64 * 72;
            f32x16 pa0, pa1;
            if (have2) {
                f32x16 pb0, pb1;
                if (w < 4) {
                    ATT_QK(kA, pa0, pa1); ATT_QK(kB, pb0, pb1); ATT_SM(mw0, pa0, pa1); ATT_PV(vA, pa0, pa1); ATT_SM(mw1, pb0, pb1); ATT_PV(vB, pb0, pb1);
                } else {
                    ATT_QK(kA, pa0, pa1); ATT_SM(mw0, pa0, pa1); ATT_QK(kB, pb0, pb1); ATT_PV(vA, pa0, pa1); ATT_SM(mw1, pb0, pb1); ATT_PV(vB, pb0, pb1);
                }
            } else { ATT_QK(kA, pa0, pa1); ATT_SM(mw0, pa0, pa1); ATT_PV(vA, pa0, pa1); }
            if (more0) { *(u32x4*)(ksm + (2 * (set ^ 1)) * 64 * 72 + srow * 72 + sc16 * 8) = kr0; *(u32x4*)(vsm + (2 * (set ^ 1)) * 64 * 72 + srow * 72 + sc16 * 8) = vr0; }
            if (more1) { *(u32x4*)(ksm + (2 * (set ^ 1) + 1) * 64 * 72 + srow * 72 + sc16 * 8) = kr1; *(u32x4*)(vsm + (2 * (set ^ 1) + 1) * 64 * 72 + srow * 72 + sc16 * 8) = vr1; }
            __syncthreads();
        }
#undef ATT_QK
#undef ATT_SM
#undef ATT_PV
        const float ltot = lsum + __shfl_xor(lsum, 32);
        const float inv = 1.0f / ltot;
        bf16* orow = O + (rowb + qb) * D + hq * 64 + 4 * hi;
#pragma unroll
        for (int v4 = 0; v4 < 4; ++v4) {
            u32x2 x; x.x = pk2(o0[4 * v4] * inv, o0[4 * v4 + 1] * inv); x.y = pk2(o0[4 * v4 + 2] * inv, o0[4 * v4 + 3] * inv);
            *(u32x2*)(orow + 8 * v4) = x;
            u32x2 y; y.x = pk2(o1[4 * v4] * inv, o1[4 * v4 + 1] * inv); y.y = pk2(o1[4 * v4 + 2] * inv, o1[4 * v4 + 3] * inv);
            *(u32x2*)(orow + 32 + 8 * v4) = y;
        }
    }
}

__device__ __forceinline__ void dsa_mixer(const Args& a, unsigned char* lds, const XcdBarrier& bar, const float* modl, int tid) {
    unsigned char* ws = a.ws;
    bf16* U = (bf16*)(ws + WS_U);
    float* PART = (float*)(ws + WS_PART); const float* BV = (const float*)(ws + WS_BIAS);
    { pg8::EpiBf16<3> E{(bf16*)(ws + WS_QKVI), DSA_N, PART, BV + BV_DSA}; run_gemm(lds, U, D, (const bf16*)(ws + WS_WDSAIN), M, DSA_N, D, E); }
    xcd_barrier(bar);
    for (int rep = 0; rep < REP_DPREP; ++rep) { dsa_prep(a, lds, tid); xcd_barrier(bar); }
#if defined(PROBE_NOSEL)
    dsa_index<false>(a, lds, tid); xcd_barrier(bar);
#endif
    for (int rep = 0; rep < REP_INDEX; ++rep) { dsa_index<true>(a, lds, tid); xcd_barrier(bar); }
#if defined(PROBE_ATTN)
    dsa_attn<PROBE_ATTN>(a, lds, tid); xcd_barrier(bar);
#endif
    dsa_attn<0>(a, lds, tid); xcd_barrier(bar);
    { pg8::EpiResid<true, false> E{a.out, a.out, modl + 5 * D, U, modl + 7 * D, PART}; run_gemm(lds, (const bf16*)(ws + WS_QN), D, (const bf16*)(ws + WS_WDSAOUT), M, D, D, E); }
    xcd_barrier(bar);
}
__device__ __forceinline__ float afma(float a, float b, float c) { float d; asm("v_fma_f32 %0, %1, %2, %3" : "=v"(d) : "v"(a), "v"(b), "v"(c)); return d; }
__device__ __forceinline__ float amul(float a, float b) { float d; asm("v_mul_f32 %0, %1, %2" : "=v"(d) : "v"(a), "v"(b)); return d; }
constexpr int EA_LD = 2048;
template <int PMODE> __device__ __forceinline__ void rwkv_scan(const Args& a, unsigned char* lds, int tid) {
    asm volatile("" : "+v"(tid));
    unsigned char* ws = a.ws;
    const bf16* RK = (const bf16*)(ws + WS_RK); const bf16* EA = (const bf16*)(ws + WS_A2); bf16* Y = (bf16*)(ws + WS_Y);
    float* vecs = (float*)lds;
    float* ybuf = (float*)(lds + 2 * 6 * 32 * 64 * 4);
    const int lane = tid & 63, w = __builtin_amdgcn_readfirstlane(tid >> 6), slice = lane & 15, rin = w * 4 + (lane >> 4);
    const int ts = tid >> 4, cgp = tid & 15;
    for (int unit = blockIdx.x; unit < 256; unit += gridDim.x) {
        const int chain = unit >> 1, half = unit & 1, b = chain >> 4, h = chain & 15;
        const size_t rowb = (size_t)b * SEQ;
        const f32x4 kkp = *(const f32x4*)(a.in[I_KK] + h * 64 + 4 * cgp), kap = *(const f32x4*)(a.in[I_KA] + h * 64 + 4 * cgp);
        u32x2 rr, rk, rv, re, ra;
#define SCAN_LOAD(c) do { const size_t row_ = rowb + (c) * 32 + ts; const bf16* p_ = RK + row_ * RW_N + h * 64 + 4 * cgp; \
            rr = *(const u32x2*)p_; rk = *(const u32x2*)(p_ + 1024); rv = *(const u32x2*)(p_ + 2048); \
            const bf16* q_ = EA + row_ * EA_LD + h * 64 + 4 * cgp; re = *(const u32x2*)q_; ra = *(const u32x2*)(q_ + 1024); } while (0)
#define SCAN_STORE(buf) do { float* base_ = vecs + (buf) * 6 * 2048 + ts * 64 + 4 * cgp; \
            const f32x4 r4 = (f32x4){bflo(rr.x), bfhi(rr.x), bflo(rr.y), bfhi(rr.y)}, k4 = (f32x4){bflo(rk.x), bfhi(rk.x), bflo(rk.y), bfhi(rk.y)}; \
            const f32x4 v4 = (f32x4){bflo(rv.x), bfhi(rv.x), bflo(rv.y), bfhi(rv.y)}, e4 = (f32x4){bflo(re.x), bfhi(re.x), bflo(re.y), bfhi(re.y)}; \
            const f32x4 a4 = (f32x4){bflo(ra.x), bfhi(ra.x), bflo(ra.y), bfhi(ra.y)}; \
            f32x4 w4; w4.x = __expf(-e4.x); w4.y = __expf(-e4.y); w4.z = __expf(-e4.z); w4.w = __expf(-e4.w); \
            const f32x4 kraw = k4 * kkp; float ss_ = (kraw.x * kraw.x + kraw.y * kraw.y) + (kraw.z * kraw.z + kraw.w * kraw.w); ss_ = row16_sum(ss_); \
            const float inv_ = __builtin_amdgcn_rsqf(fmaxf(ss_, 1e-24f)); const f32x4 kkn = kraw * inv_; \
            const f32x4 kt = k4 * ((a4 - 1.0f) * kap + 1.0f); const f32x4 bv = kkn * a4; \
            *(f32x4*)(base_) = r4; *(f32x4*)(base_ + 2048) = w4; *(f32x4*)(base_ + 2 * 2048) = kt; *(f32x4*)(base_ + 3 * 2048) = -kkn; \
            *(f32x4*)(base_ + 4 * 2048) = bv; *(f32x4*)(base_ + 5 * 2048) = v4; } while (0)
        SCAN_LOAD(0); SCAN_STORE(0);
        __syncthreads();
        float s0 = 0.f, s1 = 0.f, s2 = 0.f, s3 = 0.f;
        for (int c = 0; c < SEQ / 32; ++c) {
            const int buf = c & 1;
            if (c + 1 < SEQ / 32) SCAN_LOAD(c + 1);
            if (PMODE != 1) {
                const float* vb = vecs + buf * 6 * 2048 + 4 * slice;
                const float* vv = vecs + buf * 6 * 2048 + 5 * 2048 + half * 32 + rin;
                float* yb = ybuf + buf * 4096 + rin * 4 + (slice >> 2);
                f32x4 r4 = *(const f32x4*)(vb), w4 = *(const f32x4*)(vb + 2048), k4 = *(const f32x4*)(vb + 2 * 2048);
                f32x4 n4 = *(const f32x4*)(vb + 3 * 2048), b4 = *(const f32x4*)(vb + 4 * 2048);
                float v1 = *vv;
#pragma unroll 8
                for (int t = 0; t < 32; ++t) {
                    const int tn = (t + 1) & 31;
                    const f32x4 r4n = *(const f32x4*)(vb + tn * 64), w4n = *(const f32x4*)(vb + 2048 + tn * 64), k4n = *(const f32x4*)(vb + 2 * 2048 + tn * 64);
                    const f32x4 n4n = *(const f32x4*)(vb + 3 * 2048 + tn * 64), b4n = *(const f32x4*)(vb + 4 * 2048 + tn * 64);
                    const float v1n = vv[tn * 64];
                    float sa = afma(s1, n4.y, amul(s0, n4.x)) + afma(s3, n4.w, amul(s2, n4.z));
                    sa = row16_sum(sa);
                    s0 = afma(s0, w4.x, amul(b4.x, sa)); s1 = afma(s1, w4.y, amul(b4.y, sa)); s2 = afma(s2, w4.z, amul(b4.z, sa)); s3 = afma(s3, w4.w, amul(b4.w, sa));
                    s0 = afma(k4.x, v1, s0); s1 = afma(k4.y, v1, s1); s2 = afma(k4.z, v1, s2); s3 = afma(k4.w, v1, s3);
                    float y = afma(s1, r4.y, amul(s0, r4.x)) + afma(s3, r4.w, amul(s2, r4.z));
                    y += dppf<0xB1>(y); y += dppf<0x4E>(y);
                    yb[t * 128] = y;
                    r4 = r4n; w4 = w4n; k4 = k4n; n4 = n4n; b4 = b4n; v1 = v1n;
                }
            }
            if (c + 1 < SEQ / 32) SCAN_STORE(buf ^ 1);
            __syncthreads();
            {
                const f32x4 ya = *(const f32x4*)(ybuf + buf * 4096 + ts * 128 + 8 * cgp), yb4 = *(const f32x4*)(ybuf + buf * 4096 + ts * 128 + 8 * cgp + 4);
                *(unsigned*)(Y + (rowb + c * 32 + ts) * D + h * 64 + half * 32 + 2 * cgp) = pk2((ya.x + ya.y) + (ya.z + ya.w), (yb4.x + yb4.y) + (yb4.z + yb4.w));
            }
        }
        __syncthreads();
#undef SCAN_LOAD
#undef SCAN_STORE
    }
}

__device__ __forceinline__ void rwkv_post(const Args& a, int tid) {
    asm volatile("" : "+v"(tid));
    unsigned char* ws = a.ws;
    const bf16* RK = (const bf16*)(ws + WS_RK); const bf16* EA = (const bf16*)(ws + WS_A2); bf16* Y = (bf16*)(ws + WS_Y);
    const int lane = tid & 63, sub = lane & 15, grp = lane >> 4;
    const int gw = blockIdx.x * 8 + (tid >> 6), NGW = gridDim.x * 8;
    for (int row = gw; row < M; row += NGW) {
#pragma unroll
        for (int pass = 0; pass < 4; ++pass) {
            const int c = (pass * 4 + grp) * 64 + 4 * sub;
            const u32x2 yy = *(const u32x2*)(Y + (size_t)row * D + c);
            const bf16* p = RK + (size_t)row * RW_N + c;
            const u32x2 rr = *(const u32x2*)p, rk = *(const u32x2*)(p + 1024), rv = *(const u32x2*)(p + 2048);
            const u32x2 gg = *(const u32x2*)(EA + (size_t)row * EA_LD + c), aa = *(const u32x2*)(EA + (size_t)row * EA_LD + 1024 + c);
            const f32x4 y4 = (f32x4){bflo(yy.x), bfhi(yy.x), bflo(yy.y), bfhi(yy.y)};
            const f32x4 r4 = (f32x4){bflo(rr.x), bfhi(rr.x), bflo(rr.y), bfhi(rr.y)}, k4 = (f32x4){bflo(rk.x), bfhi(rk.x), bflo(rk.y), bfhi(rk.y)};
            const f32x4 v4 = (f32x4){bflo(rv.x), bfhi(rv.x), bflo(rv.y), bfhi(rv.y)}, g4 = (f32x4){bflo(gg.x), bfhi(gg.x), bflo(gg.y), bfhi(gg.y)};
            const f32x4 a4 = (f32x4){bflo(aa.x), bfhi(aa.x), bflo(aa.y), bfhi(aa.y)};
            const f32x4 kap = *(const f32x4*)(a.in[I_KA] + c), rkp = *(const f32x4*)(a.in[I_RK] + c), lw = *(const f32x4*)(a.in[I_LNW] + c), lb = *(const f32x4*)(a.in[I_LNB] + c);
            const float mean = row16_sum((y4.x + y4.y) + (y4.z + y4.w)) * (1.f / 64.f);
            const f32x4 d4 = y4 - mean;
            const float var = row16_sum((d4.x * d4.x + d4.y * d4.y) + (d4.z * d4.z + d4.w * d4.w)) * (1.f / 64.f);
            const float rstd = __builtin_amdgcn_rsqf(var + 64e-5f);
            const f32x4 kt = k4 * ((a4 - 1.0f) * kap + 1.0f);
            const f32x4 rkk = r4 * kt * rkp;
            const float sd = row16_sum((rkk.x + rkk.y) + (rkk.z + rkk.w));
            const f32x4 o = ((d4 * rstd) * lw + lb + v4 * sd) * g4;
            u32x2 ov; ov.x = pk2(o.x, o.y); ov.y = pk2(o.z, o.w);
            *(u32x2*)(Y + (size_t)row * D + c) = ov;
        }
    }
}

__device__ __forceinline__ void rwkv_mixer(const Args& a, unsigned char* lds, const XcdBarrier& bar, const float* modl, int tid) {
    unsigned char* ws = a.ws;
    bf16* A2 = (bf16*)(ws + WS_A2); bf16* RK = (bf16*)(ws + WS_RK); bf16* Y = (bf16*)(ws + WS_Y);
    const bf16* WL = (const bf16*)(ws + WS_WLORA);
    norm_phase(a.out, modl, 1, A2, 1, tid);
    xcd_barrier(bar);
    for (int rep = 0; rep < REP_RWIN; ++rep) { pg8::EpiBf16<1> E{RK, RW_N, nullptr, nullptr}; run_gemm(lds, A2, RW_K, (const bf16*)(ws + WS_WRWIN), M, RW_N, RW_K, E); xcd_barrier(bar); }
    { pg8::EpiBf16<2> E{A2, EA_LD, a.in[I_W0], a.in[I_A0]}; run_gemm(lds, RK + 3072, RW_N, WL, M, 2048, LORA_K, E); }
    xcd_barrier(bar);
    #if defined(PROBE_SCAN_STAGE)
    rwkv_scan<1>(a, lds, tid); xcd_barrier(bar);
#endif
    for (int rep = 0; rep < REP_SCAN; ++rep) { rwkv_scan<0>(a, lds, tid); xcd_barrier(bar); }
    { pg8::EpiBf16<0> E{A2, EA_LD, nullptr, nullptr}; run_gemm(lds, RK + 3072, RW_N, WL + (size_t)2048 * LORA_K, M, 1024, LORA_K, E); }
    xcd_barrier(bar);
    rwkv_post(a, tid);
    xcd_barrier(bar);
    { pg8::EpiResid<true, false> E{a.out, a.out, modl + 5 * D, (bf16*)(ws + WS_U), modl + 7 * D, (float*)(ws + WS_PART)}; run_gemm(lds, Y, D, (const bf16*)(ws + WS_WRWOUT), M, D, D, E); }
    xcd_barrier(bar);
}

#ifndef REP_P0
#define REP_P0 1
#endif
#ifndef REP_NORM
#define REP_NORM 1
#endif
#ifndef REP_DOWN
#define REP_DOWN 1
#endif
#ifndef REP_GU
#define REP_GU 1
#endif
#ifndef ENABLE_DSA
#define ENABLE_DSA 1
#endif
#ifndef ENABLE_RWKV
#define ENABLE_RWKV 1
#endif
template <int L> __device__ __forceinline__ void layer_body(const Args& a, unsigned char* lds, const XcdBarrier& bar, int tid) {
    unsigned char* ws = a.ws;
    const float* MOD = (const float*)(ws + WS_MOD);
    bf16* U = (bf16*)(ws + WS_U);
    bf16* ACT = (bf16*)(ws + WS_ACT);
    float* H = a.out;
    float* PART = (float*)(ws + WS_PART); const float* BV = (const float*)(ws + WS_BIAS);
#define GSYNC() xcd_barrier(bar)

        const float* modl = MOD + (size_t)L * 8 * NMOD;
        const bf16* wgu0 = (const bf16*)(ws + (L == 0 ? WS_WGU0 : WS_WGU1));
        const bf16* wdn0 = (const bf16*)(ws + (L == 0 ? WS_WDN0 : WS_WDN1));
        if (L == 0) { for (int rep = 0; rep < REP_GU; ++rep) { pg8::EpiSwiglu<false> E{ACT, DFF, nullptr, nullptr}; run_gemm(lds, U, D, wgu0, M, 2 * DFF, D, E); GSYNC(); } }
        else { pg8::EpiSwiglu<true> E{ACT, DFF, PART, BV + BV_GU1A}; run_gemm(lds, U, D, wgu0, M, 2 * DFF, D, E); GSYNC(); }
        if (L == 0) {
            for (int rep = 0; rep < REP_DOWN; ++rep) { pg8::EpiResid<true, true> E{a.in[I_X], H, modl + 2 * D, U, modl + 4 * D, PART}; run_gemm(lds, ACT, DFF, wdn0, M, D, DFF, E); GSYNC(); }
            dsa_mixer(a, lds, bar, modl, tid);
        } else {
            { pg8::EpiResid<false, true> E{H, H, modl + 2 * D, nullptr, nullptr, nullptr}; run_gemm(lds, ACT, DFF, wdn0, M, D, DFF, E); }
            GSYNC();
            rwkv_mixer(a, lds, bar, modl, tid);
        }
        { pg8::EpiSwiglu<true> E{ACT, DFF, PART, BV + (L == 0 ? BV_GU0B : BV_GU1B)}; run_gemm(lds, U, D, wgu0 + (size_t)2 * DFF * D, M, 2 * DFF, D, E); }
        GSYNC();
        if (L == 0) { pg8::EpiResid<true, true> E{H, H, modl + 8 * D, U, MOD + (size_t)8 * NMOD + D, PART}; run_gemm(lds, ACT, DFF, wdn0 + (size_t)D * DFF, M, D, DFF, E); }
        else { pg8::EpiResid<false, true> E{H, H, modl + 8 * D, nullptr, nullptr, nullptr}; run_gemm(lds, ACT, DFF, wdn0 + (size_t)D * DFF, M, D, DFF, E); }
        GSYNC();

#undef GSYNC
}
__global__ void __launch_bounds__(NTHREADS, 2) mega_fwd(Args a) {
    extern __shared__ __attribute__((aligned(16))) unsigned char lds[];
    cg::grid_group grid = cg::this_grid();
    const int tid = threadIdx.x;
    unsigned char* ws = a.ws;
    const float* MOD = (const float*)(ws + WS_MOD);
    bf16* U = (bf16*)(ws + WS_U);
    bf16* ACT = (bf16*)(ws + WS_ACT);
    float* H = a.out;

    if (tid < 2) ((volatile LAS unsigned*)((LAS unsigned char*)lds + XB_LDS_OFF))[tid] = 0u;
    __syncthreads();
    for (int rep = 0; rep < REP_P0; ++rep) { p0_prep(a, lds, tid); grid.sync(); }
    const XcdBarrier bar = xcd_barrier_post((unsigned*)(ws + WS_BAR), (volatile LAS unsigned*)((LAS unsigned char*)lds + XB_LDS_OFF));
#define GSYNC() xcd_barrier(bar)

    float* PART = (float*)(ws + WS_PART); const float* BV = (const float*)(ws + WS_BIAS);
    for (int rep = 0; rep < REP_NORM; ++rep) { norm_phase(a.in[I_X], MOD, 0, U, 0, tid); bias_phase(ws, tid); GSYNC(); }
    layer_body<0>(a, lds, bar, tid);
    layer_body<1>(a, lds, bar, tid);
}

extern "C" void kernel_launch(void* const* d_in, const int* in_sizes, int n_in, void* d_out, int out_size, void* d_ws, size_t ws_size, hipStream_t stream) {
    static int grid = 0;
    if (grid == 0) {
        if (n_in != 27 || out_size != M * D || ws_size < WS_NEED) { fprintf(stderr, "kernel_launch: unexpected shapes (n_in %d out %d ws %zu)\n", n_in, out_size, ws_size); grid = -1; return; }
        int dev = 0, cus = 0, per_cu = 0;
        hipGetDevice(&dev);
        hipDeviceGetAttribute(&cus, hipDeviceAttributeMultiprocessorCount, dev);
        hipFuncSetAttribute((const void*)mega_fwd, hipFuncAttributeMaxDynamicSharedMemorySize, LDS_BYTES);
        hipOccupancyMaxActiveBlocksPerMultiprocessor(&per_cu, (const void*)mega_fwd, NTHREADS, LDS_BYTES);
        if (per_cu < 1) per_cu = 1;
        grid = cus * per_cu;
        (void)hipGetLastError();
    }
    if (grid < 0) return;
    Args a{};
    for (int i = 0; i < 27; ++i) a.in[i] = (const float*)d_in[i];
    a.out = (float*)d_out; a.ws = (unsigned char*)d_ws;
    void* args[] = {&a};
    hipError_t e = hipLaunchCooperativeKernel((void*)mega_fwd, dim3(grid), dim3(NTHREADS), args, LDS_BYTES, stream);
    if (e != hipSuccess) fprintf(stderr, "cooperative launch failed: %s (grid %d)\n", hipGetErrorString(e), grid);
}
```

```cpp
#include <hip/hip_runtime.h>
#include <hip/hip_cooperative_groups.h>
#include <cstdio>
#include <cstdint>
namespace cg = cooperative_groups;
namespace pg8 {
#define PG8_LAS __attribute__((address_space(3)))
typedef unsigned short bf16_t;
typedef short bf16x8 __attribute__((ext_vector_type(8)));
typedef float f32x4 __attribute__((ext_vector_type(4)));
typedef unsigned u32x4 __attribute__((ext_vector_type(4)));
constexpr int BM = 256, BK = 64, HALF = 128, HTB = HALF * BK * 2  , STAGE_BYTES = 8 * HTB, NXCD = 8, WGM = 8;

__host__ __device__ __forceinline__ int lds_byte(int r, int c) { const int st = (r >> 4) * 2 + (c >> 5), rr = r & 15, cc = c & 31, ob = rr * 64 + cc * 2; return st * 1024 + (ob ^ (((ob >> 9) & 1) << 5)); }
__host__ __device__ __forceinline__ void stage_rc(int b, int& R, int& C) { const int st = b / 1024, sb = b % 1024, swz = sb ^ (((sb >> 9) & 1) << 5); R = (st >> 1) * 16 + swz / 64; C = (st & 1) * 32 + (swz % 64) / 2; }
__host__ __device__ __forceinline__ int perm32(int rho) { const int n = rho >> 4, i = rho & 15; return 8 * (i >> 2) + 4 * n + (i & 3); }

struct Unit { int pm, pn; };
struct Gemm { const bf16_t* A; const bf16_t* Bt; int M, N, K, lda; };

struct StaticOrder {
    int nM, nN, nwg, G, c;
    __host__ __device__ void init(int M, int N, int G_, int c_) { nM = M / BM; nN = N / BM; nwg = nM * nN; G = G_; c = c_; }
    __host__ __device__ bool next(int i, Unit& u) const {
        const long L = (long)i * G + c; if (L >= nwg) return false;
        int wgid = (int)L; { const int q = nwg / NXCD, r = nwg % NXCD, xcd = wgid % NXCD, off = wgid / NXCD; wgid = (xcd < r ? xcd * (q + 1) : r * (q + 1) + (xcd - r) * q) + off; }
        const int nig = WGM * nN, gid = wgid / nig, fm = gid * WGM, gsz = (nM - fm) < WGM ? (nM - fm) : WGM;
        u.pm = fm + ((wgid % nig) % gsz); u.pn = (wgid % nig) / gsz; return true;
    }
    __device__ __forceinline__ void a_ready(const Unit&) const {}
    __device__ __forceinline__ void done(const Unit&) const {}
};

__device__ __forceinline__ unsigned cvt_pk_bf16(float lo, float hi) { unsigned r; asm volatile("v_cvt_pk_bf16_f32 %0, %1, %2" : "=v"(r) : "v"(lo), "v"(hi)); return r; }
template <class Epi, class Sched, bool ALIGN_EPI = false, bool SP2 = false>
__device__ __forceinline__ void gemm_phase(PG8_LAS unsigned char* lds, const Gemm g, const Sched& S, const Epi& E) {
    int tid_ = threadIdx.x; asm volatile("" : "+v"(tid_));
    const int tid = tid_, wid = __builtin_amdgcn_readfirstlane(tid >> 6), lane = tid & 63, wr = wid >> 2, wc = wid & 3, fr = lane & 15, fq = lane >> 4;
    const int K = g.K, nt = K / BK;
    unsigned voffA[2], voffB[2];
#pragma unroll
    for (int i = 0; i < 2; ++i) { int R, C; stage_rc(tid * 16 + i * 8192, R, C); const int Rb = Epi::PERM ? ((R & ~31) + perm32(R & 31)) : R;
        voffA[i] = (unsigned)(R * g.lda + C) * 2u; voffB[i] = (unsigned)(Rb * K + C) * 2u; }
    const size_t kstep = (size_t)(BK * 2);
    const size_t hstepA = (size_t)HALF * g.lda * 2, hstepB = (size_t)HALF * K * 2;
    const size_t tstepA = 2 * hstepA, tstepB = 2 * hstepB;
    const unsigned ldsw = (unsigned)wid * 1024u;
    const int aoff = lds_byte(wr * 64 + fr, fq * 8), boff = lds_byte(wc * 32 + fr, fq * 8);
#define PG8_SA(b, h) (((b) * 2 + (h)) * HTB)
#define PG8_SB(b, h) ((4 + (b) * 2 + (h)) * HTB)
#define PG8_STAGE(bufoff, gbase, voff) do { _Pragma("unroll") for (int _i = 0; _i < 2; ++_i) \
        __builtin_amdgcn_global_load_lds((const unsigned*)((const char*)(gbase) + (voff)[_i]), (PG8_LAS unsigned*)(lds + (bufoff) + ldsw + _i * 8192), 16, 0, 0); } while (0)
#define PG8_LDA(dst, b, h) do { _Pragma("unroll") for (int m = 0; m < 4; ++m) _Pragma("unroll") for (int k = 0; k < 2; ++k) dst[m][k] = *(const PG8_LAS bf16x8*)(lds + PG8_SA(b, h) + aoff + m * 2048 + k * 1024); } while (0)
#define PG8_LDB(dst, b, h) do { _Pragma("unroll") for (int n = 0; n < 2; ++n) _Pragma("unroll") for (int k = 0; k < 2; ++k) dst[n][k] = *(const PG8_LAS bf16x8*)(lds + PG8_SB(b, h) + boff + n * 2048 + k * 1024); } while (0)
#define PG8_MMA(ai, bj, At, Bt) do { __builtin_amdgcn_s_setprio(1); _Pragma("unroll") for (int m = 0; m < 4; ++m) _Pragma("unroll") for (int n = 0; n < 2; ++n) _Pragma("unroll") for (int k = 0; k < 2; ++k) \
        acc[ai][bj][m][n] = __builtin_amdgcn_mfma_f32_16x16x32_bf16(Bt[n][k], At[m][k], acc[ai][bj][m][n], 0, 0, 0); __builtin_amdgcn_s_setprio(0); } while (0)
#define PG8_WAIT_V(n) asm volatile("s_waitcnt vmcnt(" #n ")" ::: "memory")
#define PG8_WAIT_L(n) asm volatile("s_waitcnt lgkmcnt(" #n ")" ::: "memory")
#define PG8_BAR __builtin_amdgcn_s_barrier()
#define PG8_SCHED __builtin_amdgcn_sched_barrier(0)
    Unit cur, nxt; int ui = 0;
    if (!S.next(0, cur)) return;
    f32x4 acc[2][2][4][2];
#pragma unroll
    for (int a = 0; a < 2; ++a)
#pragma unroll
        for (int b = 0; b < 2; ++b)
#pragma unroll
            for (int m = 0; m < 4; ++m)
#pragma unroll
                for (int n = 0; n < 2; ++n) acc[a][b][m][n] = (f32x4){0.f, 0.f, 0.f, 0.f};
    bf16x8 At[4][2], B0[2][2], B1[2][2];
    const char* cA = (const char*)g.A + (size_t)cur.pm * tstepA; const char* cB = (const char*)g.Bt + (size_t)cur.pn * tstepB;
    S.a_ready(cur);
    if constexpr (SP2) {
        PG8_STAGE(PG8_SB(0, 0), cB, voffB); PG8_STAGE(PG8_SB(0, 1), cB + hstepB, voffB); PG8_STAGE(PG8_SA(0, 0), cA, voffA); PG8_STAGE(PG8_SA(0, 1), cA + hstepA, voffA);
        if (wr == 1) PG8_BAR;
        PG8_WAIT_V(2); PG8_BAR;
        PG8_STAGE(PG8_SB(1, 0), cB + kstep, voffB); PG8_STAGE(PG8_SA(1, 0), cA + kstep, voffA); PG8_STAGE(PG8_SB(1, 1), cB + hstepB + kstep, voffB);
        PG8_WAIT_V(6); PG8_BAR;
    } else {
        PG8_STAGE(PG8_SB(0, 0), cB, voffB); PG8_STAGE(PG8_SA(0, 0), cA, voffA); PG8_STAGE(PG8_SB(0, 1), cB + hstepB, voffB); PG8_STAGE(PG8_SA(0, 1), cA + hstepA, voffA);
        if (wr == 1) PG8_BAR;
        PG8_WAIT_V(4); PG8_BAR;
        PG8_STAGE(PG8_SB(1, 0), cB + kstep, voffB); PG8_STAGE(PG8_SA(1, 0), cA + kstep, voffA); PG8_STAGE(PG8_SB(1, 1), cB + hstepB + kstep, voffB);
        PG8_WAIT_V(6); PG8_BAR;
    }
    for (;;) {
        const bool has_next = S.next(ui + 1, nxt);
        const char* nA = has_next ? (const char*)g.A + (size_t)nxt.pm * tstepA : cA; const char* nB = has_next ? (const char*)g.Bt + (size_t)nxt.pn * tstepB : cB;
        for (int t = 0; t < nt; t += 2) {
            const bool last = (t == nt - 2);
            const char* a1 = cA + (size_t)(t + 1) * kstep;
            const char* a2 = last ? nA : cA + (size_t)(t + 2) * kstep; const char* b2 = last ? nB : cB + (size_t)(t + 2) * kstep;
            const char* a3 = a2 + kstep; const char* b3 = b2 + kstep;
            if (last && has_next) S.a_ready(nxt);
            if constexpr (SP2) {
            PG8_LDB(B0, 0, 0); PG8_LDB(B1, 0, 1); PG8_SCHED; PG8_LDA(At, 0, 0); PG8_STAGE(PG8_SA(1, 1), a1 + hstepA, voffA);
            PG8_WAIT_V(8); PG8_WAIT_L(0); PG8_BAR; PG8_MMA(0, 0, At, B0); PG8_MMA(0, 1, At, B1); PG8_BAR; PG8_SCHED;
            PG8_LDA(At, 0, 1); PG8_STAGE(PG8_SB(0, 0), b2, voffB); PG8_STAGE(PG8_SB(0, 1), b2 + hstepB, voffB); PG8_STAGE(PG8_SA(0, 0), a2, voffA);
            PG8_WAIT_V(8); PG8_WAIT_L(0); PG8_BAR; PG8_MMA(1, 0, At, B0); PG8_MMA(1, 1, At, B1); PG8_BAR; PG8_SCHED;
            PG8_LDB(B0, 1, 0); PG8_LDB(B1, 1, 1); PG8_SCHED; PG8_LDA(At, 1, 0); PG8_STAGE(PG8_SA(0, 1), a2 + hstepA, voffA);
            PG8_WAIT_V(8); PG8_WAIT_L(0); PG8_BAR; PG8_MMA(0, 0, At, B0); PG8_MMA(0, 1, At, B1); PG8_BAR; PG8_SCHED;
            PG8_LDA(At, 1, 1); PG8_STAGE(PG8_SB(1, 0), b3, voffB); PG8_STAGE(PG8_SB(1, 1), b3 + hstepB, voffB); PG8_STAGE(PG8_SA(1, 0), a3, voffA);
            PG8_WAIT_V(8); PG8_WAIT_L(0); PG8_BAR; PG8_MMA(1, 0, At, B0); PG8_MMA(1, 1, At, B1); PG8_BAR; PG8_SCHED;
            } else {
            PG8_LDB(B0, 0, 0); PG8_SCHED; PG8_LDA(At, 0, 0); PG8_STAGE(PG8_SA(1, 1), a1 + hstepA, voffA);
            PG8_WAIT_L(8); PG8_BAR; PG8_WAIT_L(0); PG8_MMA(0, 0, At, B0); PG8_BAR; PG8_SCHED;
            PG8_LDB(B1, 0, 1); PG8_STAGE(PG8_SB(0, 0), b2, voffB);
            PG8_BAR; PG8_WAIT_L(0); PG8_MMA(0, 1, At, B1); PG8_BAR;
            PG8_LDA(At, 0, 1); PG8_STAGE(PG8_SA(0, 0), a2, voffA);
            PG8_BAR; PG8_WAIT_L(0); PG8_MMA(1, 0, At, B0); PG8_BAR; PG8_SCHED;
            PG8_STAGE(PG8_SB(0, 1), b2 + hstepB, voffB);
            PG8_WAIT_V(6); PG8_BAR; PG8_MMA(1, 1, At, B1); PG8_BAR;
            PG8_LDB(B0, 1, 0); PG8_SCHED; PG8_LDA(At, 1, 0); PG8_STAGE(PG8_SA(0, 1), a2 + hstepA, voffA);
            PG8_WAIT_L(8); PG8_BAR; PG8_WAIT_L(0); PG8_MMA(0, 0, At, B0); PG8_BAR; PG8_SCHED;
            PG8_LDB(B1, 1, 1); PG8_STAGE(PG8_SB(1, 0), b3, voffB);
            PG8_BAR; PG8_WAIT_L(0); PG8_MMA(0, 1, At, B1); PG8_BAR;
            PG8_LDA(At, 1, 1); PG8_STAGE(PG8_SA(1, 0), a3, voffA);
            PG8_BAR; PG8_WAIT_L(0); PG8_MMA(1, 0, At, B0); PG8_BAR; PG8_SCHED;
            PG8_STAGE(PG8_SB(1, 1), b3 + hstepB, voffB);
            PG8_WAIT_V(6); PG8_BAR; PG8_MMA(1, 1, At, B1); PG8_BAR;
            }
        }
        if constexpr (ALIGN_EPI) { if (wr == 0) PG8_BAR; }
        if constexpr (!Epi::AFTER_DRAIN) { E(acc, cur, wr, wc, fr, fq); S.done(cur); }
        if (!has_next) break;
#pragma unroll
        for (int a = 0; a < 2; ++a)
#pragma unroll
            for (int b = 0; b < 2; ++b)
#pragma unroll
                for (int m = 0; m < 4; ++m)
#pragma unroll
                    for (int n = 0; n < 2; ++n) acc[a][b][m][n] = (f32x4){0.f, 0.f, 0.f, 0.f};
        cur = nxt; cA = nA; cB = nB; ++ui;
        if constexpr (ALIGN_EPI) { if (wr == 1) PG8_BAR; }
    }
    PG8_WAIT_V(0);
    if constexpr (!ALIGN_EPI) { if (wr == 0) PG8_BAR; }
    PG8_BAR;
    if constexpr (Epi::AFTER_DRAIN) { E.fused(acc, cur, wr, wc, fr, fq, lds, wid, lane); S.done(cur); }
#undef PG8_SA
#undef PG8_SB
#undef PG8_STAGE
#undef PG8_LDA
#undef PG8_LDB
#undef PG8_MMA
#undef PG8_WAIT_V
#undef PG8_WAIT_L
#undef PG8_BAR
#undef PG8_SCHED
}
}
#ifndef REP_INDEX
#define REP_INDEX 1
#endif
#ifndef REP_ATTN
#define REP_ATTN 1
#endif
#ifndef REP_DPREP
#define REP_DPREP 1
#endif
#ifndef REP_SCAN
#define REP_SCAN 1
#endif
#ifndef REP_RWIN
#define REP_RWIN 1
#endif
#define LAS __attribute__((address_space(3)))
typedef unsigned short bf16;
typedef float f32x4 __attribute__((ext_vector_type(4)));
typedef float f32x2 __attribute__((ext_vector_type(2)));
typedef float f32x16 __attribute__((ext_vector_type(16)));
typedef short bf16x8 __attribute__((ext_vector_type(8)));
typedef unsigned u32x4 __attribute__((ext_vector_type(4)));
typedef unsigned u32x2 __attribute__((ext_vector_type(2)));
typedef unsigned long long u64;

constexpr int D = 1024, NB = 8, SEQ = 4096, M = NB * SEQ, DFF = 2816, NMOD = 9 * D;
constexpr int DSA_N = 2304, DSA_NREAL = 2120;
constexpr int RW_N = 3584, RW_K = 2048, LORA_K = 384;
constexpr int LDS_BYTES = 147456;
constexpr int NTHREADS = 512;
constexpr size_t MiB = 1u << 20;
constexpr size_t WS_MOD = 0;
constexpr size_t WS_BAR = 768 * 1024;
constexpr int XB_LDS_OFF = 140000;
constexpr size_t WS_L1W = 1 * MiB;
constexpr size_t WS_WGU1 = WS_L1W;
constexpr size_t WS_WDN1 = WS_WGU1 + 22 * MiB;
constexpr size_t WS_WRWIN = WS_WDN1 + 11 * MiB;
constexpr size_t WS_WLORA = WS_WRWIN + 14 * MiB;
constexpr size_t WS_WRWOUT = WS_WLORA + 3 * MiB;
constexpr size_t WS_L0W = 53 * MiB;
constexpr size_t WS_WGU0 = WS_L0W;
constexpr size_t WS_WDN0 = WS_WGU0 + 22 * MiB;
constexpr size_t WS_WDSAIN = WS_WDN0 + 11 * MiB;
constexpr size_t WS_WDSAOUT = WS_WDSAIN + 5 * MiB;
constexpr size_t WS_U = 93 * MiB;
constexpr size_t WS_ACT = 157 * MiB;
constexpr size_t WS_QKVI = 157 * MiB;
constexpr size_t WS_QN = 301 * MiB;
constexpr size_t WS_KN = 365 * MiB;
constexpr size_t WS_VT = 381 * MiB;
constexpr size_t WS_IKN = 397 * MiB;
constexpr size_t WS_IW = 401 * MiB;
constexpr size_t WS_MASK = 402 * MiB;
constexpr size_t WS_A2 = 53 * MiB;
constexpr size_t WS_RK = 181 * MiB;
constexpr size_t WS_Y = 405 * MiB;
constexpr size_t WS_BIAS = 470 * MiB;
constexpr size_t WS_PART = 471 * MiB;
constexpr size_t WS_NEED = 473 * MiB;
constexpr int BV_GU0B = 0, BV_DSA = 8 * 5632, BV_GU1A = BV_DSA + 8 * 2304, BV_GU1B = BV_GU1A + 8 * 5632;

struct Args {
    const float* in[27];
    float* out; unsigned char* ws;
};
enum { I_X = 0, I_C, I_ADAW, I_ADAB, I_WGU, I_WDN, I_DSAIN, I_QNORM, I_KNORM, I_IKNORM, I_DSAOUT, I_MU, I_WRKV, I_W0, I_W1, I_W2, I_A0, I_A1, I_A2,
       I_G1, I_G2, I_KK, I_KA, I_RK, I_LNW, I_LNB, I_RWOUT };

__device__ __forceinline__ unsigned f2bf(float f) { unsigned u = __builtin_bit_cast(unsigned, f); return (u + 0x7fffu + ((u >> 16) & 1u)) >> 16; }
typedef __bf16 hwbf16x2 __attribute__((ext_vector_type(2)));
__device__ __forceinline__ unsigned pk2(float lo, float hi) { const f32x2 v = {lo, hi}; const hwbf16x2 b = __builtin_convertvector(v, hwbf16x2); return __builtin_bit_cast(unsigned, b); }
__device__ __forceinline__ float bf2f(unsigned short b) { return __builtin_bit_cast(float, (unsigned)b << 16); }
__device__ __forceinline__ float bflo(unsigned w) { return __builtin_bit_cast(float, w << 16); }
__device__ __forceinline__ float bfhi(unsigned w) { return __builtin_bit_cast(float, w & 0xffff0000u); }
__device__ __forceinline__ float wave_sum(float v) {
#pragma unroll
    for (int o = 1; o < 64; o <<= 1) v += __shfl_xor(v, o);
    return v;
}
template <int CTRL> __device__ __forceinline__ float dppf(float v) { return __builtin_bit_cast(float, __builtin_amdgcn_mov_dpp(__builtin_bit_cast(int, v), CTRL, 0xF, 0xF, true)); }
__device__ __forceinline__ float row16_sum(float v) {
    v += dppf<0xB1>(v);
    v += dppf<0x4E>(v);
    v += dppf<0x141>(v);
    v += dppf<0x140>(v);
    return v;
}
__device__ __forceinline__ float sigmoidf_(float x) { return __builtin_amdgcn_rcpf(1.f + __expf(-x)); }
__device__ __forceinline__ float siluf_(float x) { return x * sigmoidf_(x); }

struct XDesc { const float* W; int K, N, Npad; bf16* WT; int ldo, koff, rowoff, mode; const float* kscale; };
__device__ __forceinline__ void xpose_load(const XDesc& d, int tile, int tid, float (&v)[8]) {
    const int ntn = d.Npad / 64, kb = tile / ntn, nb = tile % ntn, k0 = kb * 64, n0 = nb * 64;
    const int nn = tid & 63, n = n0 + nn;
#pragma unroll
    for (int i = 0; i < 8; ++i) {
        const int kk = (tid >> 6) + 8 * i, k = k0 + kk;
        float x = (n < d.N) ? d.W[(size_t)k * d.N + n] : 0.f;
        if (d.kscale) x *= d.kscale[k];
        v[i] = x;
    }
}
__device__ __forceinline__ void xpose_lds(const float (&v)[8], float* scr, int tid) {
#pragma unroll
    for (int i = 0; i < 8; ++i) scr[((tid >> 6) + 8 * i) * 65 + (tid & 63)] = v[i];
}
__device__ __forceinline__ void xpose_write(const XDesc& d, int tile, const float* scr, int tid) {
    const int ntn = d.Npad / 64, kb = tile / ntn, nb = tile % ntn, k0 = kb * 64, n0 = nb * 64;
    const int nl = tid >> 3, kc = (tid & 7) * 8, n = n0 + nl;
    const int orow = d.rowoff + (d.mode == 1 ? ((n % DFF) * 2 + n / DFF) : n);
    const float* s = scr + kc * 65 + nl;
    u32x4 o; o.x = pk2(s[0], s[65]); o.y = pk2(s[2 * 65], s[3 * 65]); o.z = pk2(s[4 * 65], s[5 * 65]); o.w = pk2(s[6 * 65], s[7 * 65]);
    *(u32x4*)(d.WT + (size_t)orow * d.ldo + d.koff + k0 + kc) = o;
}
__device__ __forceinline__ int xd_tiles(int K, int Npad) { return (K / 64) * (Npad / 64); }

#define P0_DECODE(it_, d, r) do { r = (it_); d.mode = 0; d.kscale = nullptr; d.koff = 0; d.rowoff = 0;\
        if (r < 4 * T_GU) { const int w = r / T_GU; r -= w * T_GU; \
            d.W = a.in[I_WGU] + (size_t)w * D * 2 * DFF; d.K = D; d.N = 2 * DFF; d.Npad = 2 * DFF; d.ldo = D; d.mode = 1;\
            d.WT = (bf16*)(ws + (w < 2 ? WS_WGU0 + (size_t)w * 11 * MiB : WS_WGU1 + (size_t)(w - 2) * 11 * MiB));\
        } else if ((r -= 4 * T_GU) < 4 * T_DN) { const int w = r / T_DN; r -= w * T_DN;\
            d.W = a.in[I_WDN] + (size_t)w * DFF * D; d.K = DFF; d.N = D; d.Npad = D; d.ldo = DFF;\
            d.WT = (bf16*)(ws + (w < 2 ? WS_WDN0 + (size_t)w * 5767168 : WS_WDN1 + (size_t)(w - 2) * 5767168));\
        } else if ((r -= 4 * T_DN) < T_DIN) {\
            d.W = a.in[I_DSAIN]; d.K = D; d.N = DSA_NREAL; d.Npad = DSA_N; d.ldo = D; d.WT = (bf16*)(ws + WS_WDSAIN);\
        } else if ((r -= T_DIN) < T_SQ) {\
            d.W = a.in[I_DSAOUT]; d.K = D; d.N = D; d.Npad = D; d.ldo = D; d.WT = (bf16*)(ws + WS_WDSAOUT);\
        } else if ((r -= T_SQ) < 6 * T_SQ) { const int w = r / T_SQ; r -= w * T_SQ; const int i = w >> 1, sec = w & 1; \
            d.W = a.in[I_WRKV] + (size_t)i * D * D; d.K = D; d.N = D; d.Npad = D; d.ldo = RW_K; d.koff = sec * D; d.rowoff = i * D;\
            d.kscale = sec ? a.in[I_MU] + i * D : nullptr; d.WT = (bf16*)(ws + WS_WRWIN);\
        } else if ((r -= 6 * T_SQ) < 4 * T_L64) { const int w = r / T_L64; r -= w * T_L64; const int i = w >> 1, sec = w & 1; \
            d.W = a.in[i == 0 ? I_W1 : I_A1]; d.K = D; d.N = 64; d.Npad = 64; d.ldo = RW_K; d.koff = sec * D; d.rowoff = 3072 + 64 * i;\
            d.kscale = sec ? a.in[I_MU] + (3 + i) * D : nullptr; d.WT = (bf16*)(ws + WS_WRWIN);\
        } else if ((r -= 4 * T_L64) < 2 * T_G1) { const int sec = r / T_G1; r -= sec * T_G1;\
            d.W = a.in[I_G1]; d.K = D; d.N = 160; d.Npad = 384; d.ldo = RW_K; d.koff = sec * D; d.rowoff = 3200;\
            d.kscale = sec ? a.in[I_MU] + 5 * D : nullptr; d.WT = (bf16*)(ws + WS_WRWIN);\
        } else { r -= 2 * T_G1;\
            d.W = a.in[I_RWOUT]; d.K = D; d.N = D; d.Npad = D; d.ldo = D; d.WT = (bf16*)(ws + WS_WRWOUT);\
        } } while (0)
__device__ __forceinline__ void p0_prep(const Args& a, unsigned char* lds, int tid) {
    asm volatile("" : "+v"(tid));
    unsigned char* ws = a.ws;
    float* scr = (float*)lds;
    float* cs = (float*)(lds + 16640);
    float* red = (float*)(lds + 16640 + 32768);
    const int G = gridDim.x, bid = blockIdx.x;
    if (bid == 0) { unsigned* bw = (unsigned*)(ws + WS_BAR); for (int i = tid; i < 3456; i += NTHREADS) bw[i] = 0u; }
    constexpr int T_GU = 16 * 88, T_DN = 44 * 16, T_DIN = 16 * 36, T_SQ = 16 * 16, T_L64 = 16 * 1, T_G1 = 16 * 6;
    constexpr int NDESC = 4 + 4 + 1 + 1 + 6 + 2 + 2 + 2 + 1;
    int total = 4 * T_GU + 4 * T_DN + T_DIN + T_SQ + 6 * T_SQ + 4 * T_L64 + 2 * T_G1 + T_SQ;
    {
        XDesc d, dn; int r = 0, rn = 0; float v[8], vn[8];
        int it = bid;
        if (it < total) { P0_DECODE(it, d, r); xpose_load(d, r, tid, v); }
        while (it < total) {
            xpose_lds(v, scr, tid);
            __syncthreads();
            const int itn = it + G;
            if (itn < total) { P0_DECODE(itn, dn, rn); xpose_load(dn, rn, tid, vn); }
            xpose_write(d, r, scr, tid);
            __syncthreads();
            d = dn; r = rn; it = itn;
#pragma unroll
            for (int i = 0; i < 8; ++i) v[i] = vn[i];
        }
    }
    (void)NDESC;
    {
        bf16* WL = (bf16*)(ws + WS_WLORA);
        for (int idx = bid * NTHREADS + tid; idx < (LORA_K / 8) * 3072; idx += G * NTHREADS) {
            const int kg = idx / 3072, n = idx % 3072, blk = n >> 10, nn = n & 1023;
            float v[8];
#pragma unroll
            for (int j = 0; j < 8; ++j) { const int k = kg * 8 + j; float x = 0.f;
                if (blk == 0) { if (k < 64) x = a.in[I_W2][(size_t)k * D + nn]; }
                else if (blk == 1) { if (k >= 64 && k < 128) x = a.in[I_A2][(size_t)(k - 64) * D + nn]; }
                else { if (k >= 128 && k < 288) x = a.in[I_G2][(size_t)(k - 128) * D + nn]; }
                v[j] = x; }
            u32x4 o; o.x = pk2(v[0], v[1]); o.y = pk2(v[2], v[3]); o.z = pk2(v[4], v[5]); o.w = pk2(v[6], v[7]);
            *(u32x4*)(WL + (size_t)n * LORA_K + kg * 8) = o;
        }
    }
    if (bid < 288) {
        for (int i = tid; i < NB * D; i += NTHREADS) cs[i] = siluf_(a.in[I_C][i]);
        __syncthreads();
        const int lane = tid & 63, w = tid >> 6;
        float* MOD = (float*)(ws + WS_MOD);
        for (int tile = bid; tile < 288; tile += G) {
            const int l = tile / 144, n = (tile % 144) * 64 + lane;
            const float* wp = a.in[I_ADAW] + ((size_t)l * D + w * 128) * NMOD + n;
            float acc[8];
#pragma unroll
            for (int b = 0; b < 8; ++b) acc[b] = 0.f;
#pragma unroll 32
            for (int k = 0; k < 128; ++k) { const float wv = wp[(size_t)k * NMOD];
#pragma unroll
                for (int b = 0; b < 8; ++b) acc[b] += cs[b * D + w * 128 + k] * wv; }
#pragma unroll
            for (int b = 0; b < 8; ++b) red[(w * 8 + b) * 64 + lane] = acc[b];
            __syncthreads();
            { const int b = tid >> 6; float s = a.in[I_ADAB][l * NMOD + n];
#pragma unroll
              for (int ww = 0; ww < 8; ++ww) s += red[(ww * 8 + b) * 64 + lane];
              MOD[(size_t)(l * 8 + b) * NMOD + n] = s; }
            __syncthreads();
        }
    }
}

__device__ __forceinline__ void norm_row(const float* hrow, const float* sh, const float* sc, int lane, f32x4 (&u)[4]) {
    float ss = 0.f;
#pragma unroll
    for (int j = 0; j < 4; ++j) { u[j] = *(const f32x4*)(hrow + 4 * lane + 256 * j); ss += (u[j].x * u[j].x + u[j].y * u[j].y) + (u[j].z * u[j].z + u[j].w * u[j].w); }
    ss = wave_sum(ss);
    const float rstd = __builtin_amdgcn_rsqf(ss * (1.f / D) + 1e-6f);
#pragma unroll
    for (int j = 0; j < 4; ++j) { const f32x4 a = *(const f32x4*)(sc + 4 * lane + 256 * j), b = *(const f32x4*)(sh + 4 * lane + 256 * j);
        u[j] = (u[j] * rstd) * (a + 1.0f) + b; }
}
__device__ __forceinline__ void norm_phase(const float* h, const float* modl  , int idx  , bf16* U, int mode, int tid) {
    asm volatile("" : "+v"(tid));
    const int lane = tid & 63, gw = blockIdx.x * 8 + (tid >> 6), NGW = gridDim.x * 8;
    for (int row = gw; row < M; row += NGW) {
        const int b = row >> 12, t = row & (SEQ - 1);
        const float* sh = modl + (size_t)b * NMOD + (idx * 3) * D; const float* sc = sh + D;
        f32x4 u[4]; norm_row(h + (size_t)row * D, sh, sc, lane, u);
        if (mode == 0) {
#pragma unroll
            for (int j = 0; j < 4; ++j) { u32x2 o; o.x = pk2(u[j].x, u[j].y); o.y = pk2(u[j].z, u[j].w); *(u32x2*)(U + (size_t)row * D + 4 * lane + 256 * j) = o; }
        } else {
            f32x4 p[4];
            if (t > 0) norm_row(h + (size_t)(row - 1) * D, sh, sc, lane, p);
            else {
#pragma unroll
                for (int j = 0; j < 4; ++j) p[j] = (f32x4){0.f, 0.f, 0.f, 0.f};
            }
#pragma unroll
            for (int j = 0; j < 4; ++j) { u32x2 o; o.x = pk2(u[j].x, u[j].y); o.y = pk2(u[j].z, u[j].w); *(u32x2*)(U + (size_t)row * RW_K + 4 * lane + 256 * j) = o;
                const f32x4 x = p[j] - u[j]; u32x2 q; q.x = pk2(x.x, x.y); q.y = pk2(x.z, x.w); *(u32x2*)(U + (size_t)row * RW_K + D + 4 * lane + 256 * j) = q; }
        }
    }
}

__device__ __forceinline__ void bias_phase(unsigned char* ws, int tid) {
    asm volatile("" : "+v"(tid));
    const int lane = tid & 63, gw = blockIdx.x * 8 + (tid >> 6), NGW = gridDim.x * 8;
    const int r16 = lane & 15, kg = lane >> 4;
    const float* MOD = (const float*)(ws + WS_MOD); float* BV = (float*)(ws + WS_BIAS);
    for (int task = gw; task < 352 * 3 + 144; task += NGW) {
        int t = task; const bf16* Bt; const float* sh; float* dst; int N;
        if (t < 352) { Bt = (const bf16*)(ws + WS_WGU0 + 11 * MiB); sh = MOD + 6 * D; dst = BV + BV_GU0B; N = 5632; }
        else if ((t -= 352) < 144) { Bt = (const bf16*)(ws + WS_WDSAIN); sh = MOD + 3 * D; dst = BV + BV_DSA; N = 2304; }
        else if ((t -= 144) < 352) { Bt = (const bf16*)(ws + WS_WGU1); sh = MOD + (size_t)8 * NMOD; dst = BV + BV_GU1A; N = 5632; }
        else { t -= 352; Bt = (const bf16*)(ws + WS_WGU1 + 11 * MiB); sh = MOD + (size_t)8 * NMOD + 6 * D; dst = BV + BV_GU1B; N = 5632; }
        const int n0 = t * 16;
        const float* ap = sh + (size_t)(r16 & 7) * NMOD + 8 * kg;
        const bf16* bp = Bt + (size_t)(n0 + r16) * D + 8 * kg;
        f32x4 acc = (f32x4){0.f, 0.f, 0.f, 0.f};
#pragma unroll 8
        for (int s = 0; s < 32; ++s) {
            const f32x4 x0 = *(const f32x4*)(ap + 32 * s), x1 = *(const f32x4*)(ap + 32 * s + 4);
            u32x4 aw; aw.x = pk2(x0.x, x0.y); aw.y = pk2(x0.z, x0.w); aw.z = pk2(x1.x, x1.y); aw.w = pk2(x1.z, x1.w);
            if (r16 >= 8) aw = (u32x4){0u, 0u, 0u, 0u};
            const bf16x8 bw = *(const bf16x8*)(bp + 32 * s);
            acc = __builtin_amdgcn_mfma_f32_16x16x32_bf16(__builtin_bit_cast(bf16x8, aw), bw, acc, 0, 0, 0);
        }
        if (kg < 2) {
#pragma unroll
            for (int v = 0; v < 4; ++v) dst[(size_t)(4 * kg + v) * N + n0 + r16] = acc[v];
        }
    }
}

namespace pg8 {
template <bool FOLD> struct EpiSwiglu {
    static constexpr bool PERM = true, AFTER_DRAIN = false;
    bf16_t* O; int ldc; const float* part; const float* biasv  ;
    __device__ __forceinline__ void operator()(const f32x4 (&acc)[2][2][4][2], const Unit& u, int wr, int wc, int fr, int fq) const {
        const int row0 = u.pm * BM + wr * 64 + fr, col0 = u.pn * BM + wc * 32 + 8 * fq;
        f32x4 bv[2][2];
        if (FOLD) { const float* bp = biasv + (size_t)(u.pm >> 4) * (2 * DFF) + col0;
#pragma unroll
            for (int bj = 0; bj < 2; ++bj) { bv[bj][0] = *(const f32x4*)(bp + bj * HALF); bv[bj][1] = *(const f32x4*)(bp + bj * HALF + 4); } }
        float rs[8];
        if (FOLD) {
#pragma unroll
            for (int i = 0; i < 8; ++i) { const f32x4 t = *(const f32x4*)(part + (size_t)(row0 + (i >> 2) * HALF + (i & 3) * 16) * 16 + 4 * fq); rs[i] = (t.x + t.y) + (t.z + t.w); }
#pragma unroll
            for (int i = 0; i < 8; ++i) { float t = rs[i]; t += __shfl_xor(t, 16); t += __shfl_xor(t, 32); rs[i] = __builtin_amdgcn_rsqf(t * (1.f / 1024.f) + 1e-6f); }
        }
#pragma unroll
        for (int ai = 0; ai < 2; ++ai)
#pragma unroll
            for (int m = 0; m < 4; ++m) { const int row = row0 + ai * HALF + m * 16; bf16_t* rowp = O + (size_t)row * ldc;
                const float rstd = FOLD ? rs[ai * 4 + m] : 1.f;
#pragma unroll
                for (int bj = 0; bj < 2; ++bj) { f32x4 v0 = acc[ai][bj][m][0], v1 = acc[ai][bj][m][1];
                    if (FOLD) { v0 = v0 * rstd + bv[bj][0]; v1 = v1 * rstd + bv[bj][1]; }
                    const float o0 = siluf_(v0[0]) * v0[1], o1 = siluf_(v0[2]) * v0[3], o2 = siluf_(v1[0]) * v1[1], o3 = siluf_(v1[2]) * v1[3];
                    u32x2 w; w.x = cvt_pk_bf16(o0, o1); w.y = cvt_pk_bf16(o2, o3);
                    *(u32x2*)(rowp + ((col0 + bj * HALF) >> 1)) = w; } }
    }
};
template <bool FOLD, bool HALFSC> struct EpiResid {
    static constexpr bool PERM = false, AFTER_DRAIN = false;
    const float* base; float* out; const float* gate  ;
    bf16_t* U2; const float* scn  ; float* part;
    __device__ __forceinline__ void operator()(const f32x4 (&acc)[2][2][4][2], const Unit& u, int wr, int wc, int fr, int fq) const {
        const int row0 = u.pm * BM + wr * 64 + fr, col0 = u.pn * BM + wc * 32 + 4 * fq;
        const float* gp = gate + (size_t)(u.pm >> 4) * NMOD;
        f32x4 gv[2][2], sv[2][2];
#pragma unroll
        for (int bj = 0; bj < 2; ++bj)
#pragma unroll
            for (int n = 0; n < 2; ++n) { gv[bj][n] = *(const f32x4*)(gp + col0 + bj * HALF + n * 16) * (HALFSC ? 0.5f : 1.0f);
                if (FOLD) sv[bj][n] = *(const f32x4*)(scn + (size_t)(u.pm >> 4) * NMOD + col0 + bj * HALF + n * 16) + 1.0f; }
#pragma unroll
        for (int ai = 0; ai < 2; ++ai)
#pragma unroll
            for (int m = 0; m < 4; ++m) { const int row = row0 + ai * HALF + m * 16; const size_t off = (size_t)row * D + col0;
                float ssq = 0.f;
#pragma unroll
                for (int bj = 0; bj < 2; ++bj)
#pragma unroll
                    for (int n = 0; n < 2; ++n) { const f32x4 bs = *(const f32x4*)(base + off + bj * HALF + n * 16);
                        const f32x4 o = bs + gv[bj][n] * acc[ai][bj][m][n];
                        *(f32x4*)(out + off + bj * HALF + n * 16) = o;
                        if (FOLD) { ssq += (o.x * o.x + o.y * o.y) + (o.z * o.z + o.w * o.w); const f32x4 q = o * sv[bj][n];
                            u32x2 w; w.x = cvt_pk_bf16(q.x, q.y); w.y = cvt_pk_bf16(q.z, q.w); *(u32x2*)(U2 + off + bj * HALF + n * 16) = w; } }
                if (FOLD) { ssq += __shfl_xor(ssq, 16); ssq += __shfl_xor(ssq, 32);
                    if (fq == 0) part[(size_t)row * 16 + (u.pn & 3) * 4 + wc] = ssq; } }
    }
};
template <int MODE> struct EpiBf16 {
    static constexpr bool PERM = true, AFTER_DRAIN = false;
    bf16_t* O; int ldc; const float* p0; const float* p1;
    __device__ __forceinline__ void operator()(const f32x4 (&acc)[2][2][4][2], const Unit& u, int wr, int wc, int fr, int fq) const {
        const int row0 = u.pm * BM + wr * 64 + fr, col0 = u.pn * BM + wc * 32 + 8 * fq;
        float rs[8];
        if (MODE == 3) {
#pragma unroll
            for (int i = 0; i < 8; ++i) { const f32x4 t = *(const f32x4*)(p0 + (size_t)(row0 + (i >> 2) * HALF + (i & 3) * 16) * 16 + 4 * fq); rs[i] = (t.x + t.y) + (t.z + t.w); }
#pragma unroll
            for (int i = 0; i < 8; ++i) { float t = rs[i]; t += __shfl_xor(t, 16); t += __shfl_xor(t, 32); rs[i] = __builtin_amdgcn_rsqf(t * (1.f / 1024.f) + 1e-6f); }
        }
#pragma unroll
        for (int bj = 0; bj < 2; ++bj) {
            const int c = col0 + bj * HALF;
            f32x4 b0 = (f32x4){0.f, 0.f, 0.f, 0.f}, b1 = b0; int kind = 0;
            if (MODE == 1) { kind = (c >= 3072 && c < 3136) ? 1 : ((c >= 3200) ? 2 : 0); }
            if (MODE == 3) { b0 = *(const f32x4*)(p1 + (size_t)(u.pm >> 4) * ldc + c); b1 = *(const f32x4*)(p1 + (size_t)(u.pm >> 4) * ldc + c + 4); }
            if (MODE == 2) { if (c < 1024) { kind = 3; b0 = *(const f32x4*)(p0 + c); b1 = *(const f32x4*)(p0 + c + 4); } else { kind = 2; b0 = *(const f32x4*)(p1 + c - 1024); b1 = *(const f32x4*)(p1 + c - 1024 + 4); } }
#pragma unroll
            for (int ai = 0; ai < 2; ++ai)
#pragma unroll
                for (int m = 0; m < 4; ++m) { bf16_t* rowp = O + (size_t)(row0 + ai * HALF + m * 16) * ldc + c;
                    f32x4 v0, v1;
                    if (MODE == 3) { const float rstd = rs[ai * 4 + m]; v0 = acc[ai][bj][m][0] * rstd + b0; v1 = acc[ai][bj][m][1] * rstd + b1; }
                    else { v0 = acc[ai][bj][m][0] + b0; v1 = acc[ai][bj][m][1] + b1; }
                    if (MODE == 1 || MODE == 2) {
#pragma unroll
                        for (int e = 0; e < 4; ++e) {
                            if (kind == 1) { v0[e] = 2.f * sigmoidf_(2.f * v0[e]) - 1.f; v1[e] = 2.f * sigmoidf_(2.f * v1[e]) - 1.f; }
                            else if (kind == 2) { v0[e] = sigmoidf_(v0[e]); v1[e] = sigmoidf_(v1[e]); }
                            else if (kind == 3) { v0[e] = 0.60653066f * sigmoidf_(v0[e]); v1[e] = 0.60653066f * sigmoidf_(v1[e]); }
                        }
                    }
                    u32x4 w; w.x = cvt_pk_bf16(v0[0], v0[1]); w.y = cvt_pk_bf16(v0[2], v0[3]); w.z = cvt_pk_bf16(v1[0], v1[1]); w.w = cvt_pk_bf16(v1[2], v1[3]);
                    *(u32x4*)rowp = w; }
        }
    }
};
}

template <bool ALIGN = true, class Epi> __device__ __forceinline__ void run_gemm(unsigned char* lds, const bf16* A, int lda, const bf16* Bt, int Mrows, int N, int K, const Epi& E) {
    asm volatile("" : "+s"(A), "+s"(Bt), "+s"(K));
    pg8::Gemm g{A, Bt, Mrows, N, K, lda}; pg8::StaticOrder S; S.init(Mrows, N, (int)gridDim.x, (int)blockIdx.x);
    pg8::gemm_phase<Epi, pg8::StaticOrder, ALIGN, true>((PG8_LAS unsigned char*)lds, g, S, E);
}
#define XB_TMO      128
#define XB_XCNT(j)  (256  + 64 * (j))
#define XB_XSUB(j)  (1280 + 64 * (j))
#define XB_XGEN(j)  (2304 + 64 * (j))
#define XB_TOP      3328
#define XB_TOPGEN   3392
#define XCD_BAR_WORDS 3456
#define XB_SPIN_CAP (1u << 18)

__device__ __forceinline__ unsigned xb_ld(unsigned* p)              { return __hip_atomic_load(p, __ATOMIC_RELAXED, __HIP_MEMORY_SCOPE_AGENT); }
__device__ __forceinline__ unsigned xb_add(unsigned* p, unsigned v) { return __hip_atomic_fetch_add(p, v, __ATOMIC_RELAXED, __HIP_MEMORY_SCOPE_AGENT); }
__device__ __forceinline__ unsigned xb_xcc_id() { return (unsigned)__builtin_amdgcn_s_getreg((3 << 11) | 20) & 0xFu; }
#define XB_SPIN(cond, bar) do { unsigned _sp = 0; while (cond) { __builtin_amdgcn_s_sleep(1); \
    if ((++_sp & 255u) == 0u) { if (xb_ld(&(bar)[XB_TMO])) break; if (_sp > XB_SPIN_CAP) { atomicAdd(&(bar)[XB_TMO], 1u); break; } } } } while (0)

struct XcdBarrier {
    unsigned* bar; unsigned x;
    volatile LAS unsigned* st;
};

__device__ __forceinline__ XcdBarrier xcd_barrier_post(unsigned* bar, volatile LAS unsigned* st) {
    XcdBarrier b; b.bar = bar; b.x = xb_xcc_id(); b.st = st;
    if (threadIdx.x == 0) (void)xb_add(&bar[XB_XCNT(b.x)], 1u);
    return b;
}
__device__ __forceinline__ void xcd_barrier_complete(unsigned* bar, unsigned x, unsigned& nloc, unsigned& nx) {
    const unsigned G = gridDim.x * gridDim.y * gridDim.z;
    unsigned sum, cnt, mine, sp = 0u;
    for (;;) {
        sum = 0u; cnt = 0u; mine = 0u;
#pragma unroll
        for (unsigned j = 0; j < 16; ++j) { const unsigned c = xb_ld(&bar[XB_XCNT(j)]); sum += c; cnt += (c > 0u) ? 1u : 0u; mine = (j == x) ? c : mine; }
        if (sum == G) break;
        __builtin_amdgcn_s_sleep(1);
        if ((++sp & 255u) == 0u) { if (xb_ld(&bar[XB_TMO])) break; if (sp > XB_SPIN_CAP) { atomicAdd(&bar[XB_TMO], 1u); break; } }
    }
    nloc = mine > 0u ? mine : 1u; nx = cnt > 0u ? cnt : 1u;
}

__device__ __forceinline__ void xcd_barrier(const XcdBarrier& b) {
    asm volatile("s_waitcnt vmcnt(0)" ::: "memory");
    __syncthreads();
    if (threadIdx.x == 0) {
        unsigned* bar = b.bar;
        __builtin_amdgcn_s_waitcnt(0);
        unsigned nloc = b.st[0], nx = b.st[1];
        if (nloc == 0u) { xcd_barrier_complete(bar, b.x, nloc, nx); b.st[0] = nloc; b.st[1] = nx; }
        const unsigned old = xb_add(&bar[XB_XSUB(b.x)], 1u);
        const unsigned gen = old / nloc;
        if (old + 1u == (gen + 1u) * nloc) {
            __builtin_amdgcn_fence(__ATOMIC_RELEASE, "agent");
            asm volatile("s_waitcnt vmcnt(0)" ::: "memory");
            const unsigned og = xb_add(&bar[XB_TOP], 1u);
            const unsigned tg = og / nx;
            if (og + 1u == (tg + 1u) * nx) xb_add(&bar[XB_TOPGEN], 1u);
            else XB_SPIN(xb_ld(&bar[XB_TOPGEN]) == tg, bar);
            __builtin_amdgcn_fence(__ATOMIC_ACQUIRE, "agent");
            xb_add(&bar[XB_XGEN(b.x)], 1u);
            asm volatile("s_waitcnt vmcnt(0)" ::: "memory");
        } else {
            XB_SPIN(xb_ld(&bar[XB_XGEN(b.x)]) == gen, bar);
            __builtin_amdgcn_fence(__ATOMIC_ACQUIRE, "agent");
            asm volatile("s_waitcnt vmcnt(0)" ::: "memory");
        }
    }
    __syncthreads();
}

constexpr int QKVI_LD = DSA_N;
constexpr float QSCALE = 0.18033688011112042f;
constexpr float IWSCALE = 0.04419417382415922f;

__device__ __forceinline__ void dsa_prep(const Args& a, unsigned char* lds, int tid) {
    asm volatile("" : "+v"(tid));
    unsigned char* ws = a.ws;
    const bf16* QKVI = (const bf16*)(ws + WS_QKVI);
    bf16* QN = (bf16*)(ws + WS_QN); bf16* KN = (bf16*)(ws + WS_KN); bf16* VT = (bf16*)(ws + WS_VT); bf16* IKN = (bf16*)(ws + WS_IKN); float* IW = (float*)(ws + WS_IW);
    bf16* vt = (bf16*)lds;
    const int lane = tid & 63, w = tid >> 6, sub = lane & 15, grp = lane >> 4;
    const f32x4 qn = *(const f32x4*)(a.in[I_QNORM] + 4 * sub), kn = *(const f32x4*)(a.in[I_KNORM] + 4 * sub), ikn = *(const f32x4*)(a.in[I_IKNORM] + 4 * sub);
    for (int blk = blockIdx.x; blk < M / 64; blk += gridDim.x) {
        const int t0 = blk * 64, b = t0 >> 12, tt0 = t0 & (SEQ - 1);
#pragma unroll 4
        for (int i = 0; i < 8; ++i) {
            const int row = t0 + 8 * w + i;
            const bf16* src = QKVI + (size_t)row * QKVI_LD;
#pragma unroll
            for (int j = 0; j < 5; ++j) {
                const int hh = j * 4 + grp, col = hh * 64 + 4 * sub;
                const u32x2 x = *(const u32x2*)(src + col);
                f32x4 v = (f32x4){bflo(x.x), bfhi(x.x), bflo(x.y), bfhi(x.y)};
                float ss = (v.x * v.x + v.y * v.y) + (v.z * v.z + v.w * v.w);
                ss = row16_sum(ss);
                const float rstd = __builtin_amdgcn_rsqf(ss * (1.f / 64.f) + 1e-6f);
                if (j < 4) { v = v * rstd * qn * QSCALE; u32x2 o; o.x = pk2(v.x, v.y); o.y = pk2(v.z, v.w); *(u32x2*)(QN + (size_t)row * D + col) = o; }
                else { v = v * rstd * kn; u32x2 o; o.x = pk2(v.x, v.y); o.y = pk2(v.z, v.w); *(u32x2*)(KN + (size_t)row * 256 + (col - 1024)) = o; }
            }
            {
                const u32x2 x = *(const u32x2*)(src + 2048 + 4 * sub);
                f32x4 v = (f32x4){bflo(x.x), bfhi(x.x), bflo(x.y), bfhi(x.y)};
                float ss = (v.x * v.x + v.y * v.y) + (v.z * v.z + v.w * v.w);
                ss = row16_sum(ss);
                const float rstd = __builtin_amdgcn_rsqf(ss * (1.f / 64.f) + 1e-6f);
                v = v * rstd * ikn;
                if (grp == 0) { u32x2 o; o.x = pk2(v.x, v.y); o.y = pk2(v.z, v.w); *(u32x2*)(IKN + (size_t)row * 64 + 4 * sub) = o; }
                if (lane < 8) IW[(size_t)row * 8 + lane] = bf2f(src[2112 + lane]) * IWSCALE;
            }
        }
        for (int task = tid; task < 64 * 64; task += NTHREADS) {
            const int tok = task >> 6, c4 = task & 63;
            const u32x2 x = *(const u32x2*)(QKVI + (size_t)(t0 + tok) * QKVI_LD + 1280 + 4 * c4);
            vt[(4 * c4 + 0) * 72 + tok] = (bf16)(x.x & 0xffffu); vt[(4 * c4 + 1) * 72 + tok] = (bf16)(x.x >> 16);
            vt[(4 * c4 + 2) * 72 + tok] = (bf16)(x.y & 0xffffu); vt[(4 * c4 + 3) * 72 + tok] = (bf16)(x.y >> 16);
        }
        __syncthreads();
        {
            const int col = tid >> 1, half = tid & 1;
            bf16* dst = VT + ((size_t)(b * 4 + (col >> 6)) * 64 + (col & 63)) * SEQ + tt0 + half * 32;
#pragma unroll
            for (int i = 0; i < 4; ++i) *(u32x4*)(dst + 8 * i) = *(const u32x4*)(vt + col * 72 + half * 32 + 8 * i);
        }
        __syncthreads();
    }
}

__device__ __forceinline__ u64 cmp_ge_mask(unsigned v, unsigned c) { u64 m; asm("v_cmp_ge_u32_e64 %0, %1, %2" : "=s"(m) : "v"(v), "s"(c)); return m; }
__device__ __forceinline__ unsigned f2key(float f) { const unsigned u = __builtin_bit_cast(unsigned, f); return (u & 0x80000000u) ? ~u : (u | 0x80000000u); }

template <bool DO_SELECT> __device__ __forceinline__ void dsa_index(const Args& a, unsigned char* lds, int tid) {
    asm volatile("" : "+v"(tid));
    unsigned char* ws = a.ws;
    const bf16* QKVI = (const bf16*)(ws + WS_QKVI); const bf16* IKN = (const bf16*)(ws + WS_IKN); const float* IW = (const float*)(ws + WS_IW);
    u64* MASK = (u64*)(ws + WS_MASK);
    float* scl = (float*)lds;
    const int lane = tid & 63, w = __builtin_amdgcn_readfirstlane(tid >> 6), hi = lane >> 5, l32 = lane & 31;
    const int G = gridDim.x;
    const int a_ql = 2 * ((l32 >> 2) & 1) + (l32 >> 4), a_h = ((l32 >> 3) & 1) * 4 + (l32 & 3);
    bf16x8 af[2][4];
    f32x4 iwv[2][2][2];
#define IDX_LOAD_UNIT(r_) do { const int b_ = (r_) >> 9; int qi_ = (r_) & 511; if (((r_) >> 9) & 1) qi_ = 511 - qi_; \
        const size_t row0_ = (size_t)b_ * SEQ + qi_ * 8; \
        _Pragma("unroll") for (int rb = 0; rb < 2; ++rb) _Pragma("unroll") for (int ks = 0; ks < 4; ++ks) \
            af[rb][ks] = *(const bf16x8*)(QKVI + (row0_ + rb * 4 + a_ql) * QKVI_LD + 1536 + a_h * 64 + 16 * ks + 8 * hi); \
        _Pragma("unroll") for (int rb = 0; rb < 2; ++rb) _Pragma("unroll") for (int jj = 0; jj < 2; ++jj) { \
            const float* ip = IW + (row0_ + rb * 4 + 2 * hi + jj) * 8; iwv[rb][jj][0] = *(const f32x4*)ip; iwv[rb][jj][1] = *(const f32x4*)(ip + 4); } } while (0)
    if ((int)blockIdx.x < M / 8) IDX_LOAD_UNIT((int)blockIdx.x);
    for (int r = blockIdx.x; r < M / 8; r += G) {
        const int b = r >> 9; int qi = r & 511; if ((r >> 9) & 1) qi = 511 - qi;
        const int q0 = qi * 8, nch = (q0 >> 6) + 1;
        const size_t rowb = (size_t)b * SEQ;
        for (int ch = w; ch < nch; ch += 8) {
#pragma unroll
            for (int cb = 0; cb < 2; ++cb) {
                bf16x8 bfr[4];
#pragma unroll
                for (int ks = 0; ks < 4; ++ks) bfr[ks] = *(const bf16x8*)(IKN + (rowb + ch * 64 + cb * 32 + l32) * 64 + 16 * ks + 8 * hi);
                const int key = ch * 64 + cb * 32 + l32;
#pragma unroll
                for (int rb = 0; rb < 2; ++rb) {
                    f32x16 acc;
#pragma unroll
                    for (int e = 0; e < 16; ++e) acc[e] = 0.f;
#pragma unroll
                    for (int ks = 0; ks < 4; ++ks) acc = __builtin_amdgcn_mfma_f32_32x32x16_bf16(af[rb][ks], bfr[ks], acc, 0, 0, 0);
#pragma unroll
                    for (int jj = 0; jj < 2; ++jj) {
                        float sc = 0.f;
#pragma unroll
                        for (int e = 0; e < 8; ++e) sc = fmaf(fmaxf(acc[8 * jj + e], 0.f), iwv[rb][jj][e >> 2][e & 3], sc);
                        const int q = rb * 4 + 2 * hi + jj;
                        if (key > q0 + q) sc = -INFINITY;
                        scl[q * SEQ + key] = sc;
                    }
                }
            }
        }
        __syncthreads();
        if (r + G < M / 8) IDX_LOAD_UNIT(r + G);
        if (DO_SELECT) {
            const int q = q0 + w, nreg = (q >> 6) + 1;
            unsigned u[64];
#pragma unroll
            for (int i = 0; i < 64; ++i) {
                unsigned v = 0u;
                if (i < nreg) { const int key = i * 64 + lane; const float f = scl[w * SEQ + key]; v = (key <= q) ? f2key(f) : 0u; }
                u[i] = v;
            }
            u64 myword = 0ull;
            if (q + 1 <= 256) {
#pragma unroll
                for (int i = 0; i < 64; ++i) { const u64 wd = __ballot(i * 64 + lane <= q); if (lane == i) myword = wd; }
            } else {
                unsigned prefix = 0u, ecand = 0u; bool exact = false;
                for (int bit = 31; bit >= 0; --bit) {
                    const unsigned cand = prefix | (1u << bit);
                    int cnt = 0;
#pragma unroll
                    for (int g = 0; g < 8; ++g) {
                        if (g * 8 < nreg) {
                            u64 m0, m1, m2, m3, m4, m5, m6, m7;
                            asm("v_cmp_ge_u32_e64 %0, %8, %16\n\tv_cmp_ge_u32_e64 %1, %9, %16\n\tv_cmp_ge_u32_e64 %2, %10, %16\n\tv_cmp_ge_u32_e64 %3, %11, %16\n\t"
                                "v_cmp_ge_u32_e64 %4, %12, %16\n\tv_cmp_ge_u32_e64 %5, %13, %16\n\tv_cmp_ge_u32_e64 %6, %14, %16\n\tv_cmp_ge_u32_e64 %7, %15, %16"
                                : "=&s"(m0), "=&s"(m1), "=&s"(m2), "=&s"(m3), "=&s"(m4), "=&s"(m5), "=&s"(m6), "=&s"(m7)
                                : "v"(u[g * 8 + 0]), "v"(u[g * 8 + 1]), "v"(u[g * 8 + 2]), "v"(u[g * 8 + 3]), "v"(u[g * 8 + 4]), "v"(u[g * 8 + 5]), "v"(u[g * 8 + 6]), "v"(u[g * 8 + 7]), "s"(cand));
                            cnt += (__builtin_popcountll(m0) + __builtin_popcountll(m1)) + (__builtin_popcountll(m2) + __builtin_popcountll(m3))
                                 + (__builtin_popcountll(m4) + __builtin_popcountll(m5)) + (__builtin_popcountll(m6) + __builtin_popcountll(m7));
                        }
                    }
                    if (cnt == 256) { exact = true; ecand = cand; break; }
                    if (cnt > 256) prefix = cand;
                }
                if (exact) {
#pragma unroll
                    for (int i = 0; i < 64; ++i) { const u64 wd = __ballot(u[i] >= ecand); if (lane == i) myword = wd; }
                } else {
                    const unsigned T = prefix;
                    int ngt = 0;
#pragma unroll
                    for (int i = 0; i < 64; ++i) ngt += __builtin_popcountll(__ballot(u[i] > T));
                    int need = 256 - ngt;
#pragma unroll
                    for (int i = 0; i < 64; ++i) {
                        const u64 gt = __ballot(u[i] > T); u64 eq = __ballot(u[i] == T);
                        while (__builtin_popcountll(eq) > need) eq &= ~(1ull << (63 - __builtin_clzll(eq)));
                        need -= __builtin_popcountll(eq);
                        const u64 wd = gt | eq; if (lane == i) myword = wd;
                    }
                }
            }
            MASK[(rowb + q) * 64 + lane] = myword;
        }
        __syncthreads();
    }
}

template <int PV> __device__ __forceinline__ void dsa_attn(const Args& a, unsigned char* lds, int tid) {
    asm volatile("" : "+v"(tid));
    unsigned char* ws = a.ws;
    const bf16* QN = (const bf16*)(ws + WS_QN); const bf16* KN = (const bf16*)(ws + WS_KN); const bf16* VT = (const bf16*)(ws + WS_VT);
    const u64* MASK = (const u64*)(ws + WS_MASK);
    bf16* O = (bf16*)(ws + (PV == 0 ? WS_QN : WS_U));
    bf16* ksm = (bf16*)lds;
    bf16* vsm = (bf16*)(lds + 4 * 64 * 72 * 2);
    const int lane = tid & 63, w = __builtin_amdgcn_readfirstlane(tid >> 6), hi = lane >> 5, l32 = lane & 31;
    const int srow = tid >> 3, sc16 = tid & 7;
    float nB;
    { float mq = fabsf(a.in[I_QNORM][lane]), mk = fabsf(a.in[I_KNORM][lane]);
#pragma unroll
      for (int o = 1; o < 64; o <<= 1) { mq = fmaxf(mq, __shfl_xor(mq, o)); mk = fmaxf(mk, __shfl_xor(mk, o)); }
      nB = -(64.0f * QSCALE * 1.02f) * mq * mk; }
    for (int c = blockIdx.x; c < 256; c += gridDim.x)
    for (int k = 0; k < 8; ++k) {
        const int vc = (gridDim.x == 256) ? ((c & 7) * 32 + (c >> 3)) : c;
        const int bg = (vc >> 6) + 4 * k, b = bg >> 2, g = bg & 3;
        int qt = vc & 63; if (k & 1) qt = 63 - qt;
        const int hq = g * 4 + (w & 3), qb = qt * 64 + (w >> 2) * 32 + l32;
        const size_t rowb = (size_t)b * SEQ;
        const int ntile = qt + 1;
        bf16x8 qf[4];
#pragma unroll
        for (int ks = 0; ks < 4; ++ks) qf[ks] = *(const bf16x8*)(QN + (rowb + qb) * D + hq * 64 + 16 * ks + 8 * hi);
        const bf16* kg = KN + (rowb + srow) * 256 + g * 64 + sc16 * 8;
        const bf16* vg = VT + ((size_t)(b * 4 + g) * 64 + srow) * SEQ + sc16 * 8;
        const u64* mrow = MASK + (rowb + qb) * 64;
        u32x4 kr0 = *(const u32x4*)kg, vr0 = *(const u32x4*)vg, kr1 = kr0, vr1 = vr0;
        if (ntile > 1) { kr1 = *(const u32x4*)(kg + (size_t)64 * 256); vr1 = *(const u32x4*)(vg + 64); }
        *(u32x4*)(ksm + srow * 72 + sc16 * 8) = kr0; *(u32x4*)(vsm + srow * 72 + sc16 * 8) = vr0;
        *(u32x4*)(ksm + 64 * 72 + srow * 72 + sc16 * 8) = kr1; *(u32x4*)(vsm + 64 * 72 + srow * 72 + sc16 * 8) = vr1;
        __syncthreads();
        f32x16 o0, o1;
#pragma unroll
        for (int e = 0; e < 16; ++e) { o0[e] = 0.f; o1[e] = 0.f; }
        float lsum = 0.f;
        u64 mwa = mrow[0], mwb = (ntile > 1) ? mrow[1] : 0ull;
#define ATT_QK(KB_, P0, P1) do { const bf16* kb_ = (KB_); \
            _Pragma("unroll") for (int e = 0; e < 16; ++e) { P0[e] = nB; P1[e] = nB; } \
            if (PV != 4) _Pragma("unroll") for (int ks = 0; ks < 4; ++ks) { \
                const bf16x8 ka = *(const bf16x8*)(kb_ + l32 * 72 + 16 * ks + 8 * hi); \
                const bf16x8 kc = *(const bf16x8*)(kb_ + (32 + l32) * 72 + 16 * ks + 8 * hi); \
                P0 = __builtin_amdgcn_mfma_f32_32x32x16_bf16(ka, qf[ks], P0, 0, 0, 0); \
                P1 = __builtin_amdgcn_mfma_f32_32x32x16_bf16(kc, qf[ks], P1, 0, 0, 0); } } while (0)
#define ATT_SM(MW_, P0, P1) do { const u64 mw = (MW_); \
            const unsigned m0 = (unsigned)mw >> (4 * hi), m1 = (unsigned)(mw >> 32) >> (4 * hi); \
            float ps = 0.f, ps2 = 0.f; \
            if (PV != 2) _Pragma("unroll") for (int v = 0; v < 16; ++v) { \
                const int cbit = 8 * (v >> 2) + (v & 3); \
                int t0, t1; asm("v_bfe_i32 %0, %1, %2, 1" : "=v"(t0) : "v"(m0), "n"(cbit)); asm("v_bfe_i32 %0, %1, %2, 1" : "=v"(t1) : "v"(m1), "n"(cbit)); \
                P0[v] = __builtin_bit_cast(float, __builtin_bit_cast(int, __builtin_amdgcn_exp2f(P0[v])) & t0); \
                P1[v] = __builtin_bit_cast(float, __builtin_bit_cast(int, __builtin_amdgcn_exp2f(P1[v])) & t1); \
                asm("v_add_f32 %0, %1, %0" : "+v"(ps) : "v"(P0[v])); asm("v_add_f32 %0, %1, %0" : "+v"(ps2) : "v"(P1[v])); } \
            lsum += ps + ps2; } while (0)
#define ATT_PV(VB_, P0, P1) do { const bf16* vb_ = (VB_); \
            if (PV == 3) { lsum += P0[0] + P1[5]; } else \
            _Pragma("unroll") for (int kb = 0; kb < 2; ++kb) \
            _Pragma("unroll") for (int s = 0; s < 2; ++s) { \
                    u32x4 pb; \
                    if (kb == 0) { pb.x = pk2(P0[8 * s + 0], P0[8 * s + 1]); pb.y = pk2(P0[8 * s + 2], P0[8 * s + 3]); pb.z = pk2(P0[8 * s + 4], P0[8 * s + 5]); pb.w = pk2(P0[8 * s + 6], P0[8 * s + 7]); } \
                    else         { pb.x = pk2(P1[8 * s + 0], P1[8 * s + 1]); pb.y = pk2(P1[8 * s + 2], P1[8 * s + 3]); pb.z = pk2(P1[8 * s + 4], P1[8 * s + 5]); pb.w = pk2(P1[8 * s + 6], P1[8 * s + 7]); } \
                    const bf16x8 pbv = __builtin_bit_cast(bf16x8, pb); \
                    const int base = kb * 32 + 16 * s + 4 * hi; \
                    { const u32x2 lo = *(const u32x2*)(vb_ + l32 * 72 + base), hi2 = *(const u32x2*)(vb_ + l32 * 72 + base + 8); \
                      const u32x4 va = (u32x4){lo.x, lo.y, hi2.x, hi2.y}; \
                      o0 = __builtin_amdgcn_mfma_f32_32x32x16_bf16(__builtin_bit_cast(bf16x8, va), pbv, o0, 0, 0, 0); } \
                    { const u32x2 lo = *(const u32x2*)(vb_ + (32 + l32) * 72 + base), hi2 = *(const u32x2*)(vb_ + (32 + l32) * 72 + base + 8); \
                      const u32x4 va = (u32x4){lo.x, lo.y, hi2.x, hi2.y}; \
                      o1 = __builtin_amdgcn_mfma_f32_32x32x16_bf16(__builtin_bit_cast(bf16x8, va), pbv, o1, 0, 0, 0); } } \
        } while (0)
        for (int j = 0; j < ntile; j += 2) {
            const int set = (j >> 1) & 1;
            const bool have2 = (j + 1 < ntile), more0 = (j + 2 < ntile), more1 = (j + 3 < ntile);
            if (more0) { kr0 = *(const u32x4*)(kg + (size_t)(j + 2) * 64 * 256); vr0 = *(const u32x4*)(vg + (j + 2) * 64); }
            if (more1) { kr1 = *(const u32x4*)(kg + (size_t)(j + 3) * 64 * 256); vr1 = *(const u32x4*)(vg + (j + 3) * 64); }
            const u64 mw0 = mwa, mw1 = mwb;
            if (more0) mwa = mrow[j + 2];
            if (more1) mwb = mrow[j + 3];
            const bf16* kA = ksm + (2 * set) * 64 * 72; const bf16* vA = vsm + (2 * set) * 64 * 72;
            const bf16* kB = kA + 64 * 72; const bf16* vB = vA + 64 * 72;
            f32x16 pa0, pa1;
            if (have2) {
                f32x16 pb0, pb1;
                if (w < 4) {
                    ATT_QK(kA, pa0, pa1); ATT_QK(kB, pb0, pb1); ATT_SM(mw0, pa0, pa1); ATT_PV(vA, pa0, pa1); ATT_SM(mw1, pb0, pb1); ATT_PV(vB, pb0, pb1);
                } else {
                    ATT_QK(kA, pa0, pa1); ATT_SM(mw0, pa0, pa1); ATT_QK(kB, pb0, pb1); ATT_PV(vA, pa0, pa1); ATT_SM(mw1, pb0, pb1); ATT_PV(vB, pb0, pb1);
                }
            } else { ATT_QK(kA, pa0, pa1); ATT_SM(mw0, pa0, pa1); ATT_PV(vA, pa0, pa1); }
            if (more0) { *(u32x4*)(ksm + (2 * (set ^ 1)) * 64 * 72 + srow * 72 + sc16 * 8) = kr0; *(u32x4*)(vsm + (2 * (set ^ 1)) * 64 * 72 + srow * 72 + sc16 * 8) = vr0; }
            if (more1) { *(u32x4*)(ksm + (2 * (set ^ 1) + 1) * 64 * 72 + srow * 72 + sc16 * 8) = kr1; *(u32x4*)(vsm + (2 * (set ^ 1) + 1) * 64 * 72 + srow * 72 + sc16 * 8) = vr1; }
            __syncthreads();
        }
#undef ATT_QK
#undef ATT_SM
#undef ATT_PV
        const float ltot = lsum + __shfl_xor(lsum, 32);
        const float inv = 1.0f / ltot;
        bf16* orow = O + (rowb + qb) * D + hq * 64 + 4 * hi;
#pragma unroll
        for (int v4 = 0; v4 < 4; ++v4) {
            u32x2 x; x.x = pk2(o0[4 * v4] * inv, o0[4 * v4 + 1] * inv); x.y = pk2(o0[4 * v4 + 2] * inv, o0[4 * v4 + 3] * inv);
            *(u32x2*)(orow + 8 * v4) = x;
            u32x2 y; y.x = pk2(o1[4 * v4] * inv, o1[4 * v4 + 1] * inv); y.y = pk2(o1[4 * v4 + 2] * inv, o1[4 * v4 + 3] * inv);
            *(u32x2*)(orow + 32 + 8 * v4) = y;
        }
    }
}

__device__ __forceinline__ void dsa_mixer(const Args& a, unsigned char* lds, const XcdBarrier& bar, const float* modl, int tid) {
    unsigned char* ws = a.ws;
    bf16* U = (bf16*)(ws + WS_U);
    float* PART = (float*)(ws + WS_PART); const float* BV = (const float*)(ws + WS_BIAS);
    { pg8::EpiBf16<3> E{(bf16*)(ws + WS_QKVI), DSA_N, PART, BV + BV_DSA}; run_gemm(lds, U, D, (const bf16*)(ws + WS_WDSAIN), M, DSA_N, D, E); }
    xcd_barrier(bar);
    for (int rep = 0; rep < REP_DPREP; ++rep) { dsa_prep(a, lds, tid); xcd_barrier(bar); }
#if defined(PROBE_NOSEL)
    dsa_index<false>(a, lds, tid); xcd_barrier(bar);
#endif
    for (int rep = 0; rep < REP_INDEX; ++rep) { dsa_index<true>(a, lds, tid); xcd_barrier(bar); }
#if defined(PROBE_ATTN)
    dsa_attn<PROBE_ATTN>(a, lds, tid); xcd_barrier(bar);
#endif
    dsa_attn<0>(a, lds, tid); xcd_barrier(bar);
    { pg8::EpiResid<true, false> E{a.out, a.out, modl + 5 * D, U, modl + 7 * D, PART}; run_gemm(lds, (const bf16*)(ws + WS_QN), D, (const bf16*)(ws + WS_WDSAOUT), M, D, D, E); }
    xcd_barrier(bar);
}
__device__ __forceinline__ float afma(float a, float b, float c) { float d; asm("v_fma_f32 %0, %1, %2, %3" : "=v"(d) : "v"(a), "v"(b), "v"(c)); return d; }
__device__ __forceinline__ float amul(float a, float b) { float d; asm("v_mul_f32 %0, %1, %2" : "=v"(d) : "v"(a), "v"(b)); return d; }
constexpr int EA_LD = 2048;
template <int PMODE> __device__ __forceinline__ void rwkv_scan(const Args& a, unsigned char* lds, int tid) {
    asm volatile("" : "+v"(tid));
    unsigned char* ws = a.ws;
    const bf16* RK = (const bf16*)(ws + WS_RK); const bf16* EA = (const bf16*)(ws + WS_A2); bf16* Y = (bf16*)(ws + WS_Y);
    float* vecs = (float*)lds;
    float* ybuf = (float*)(lds + 2 * 6 * 32 * 64 * 4);
    const int lane = tid & 63, w = __builtin_amdgcn_readfirstlane(tid >> 6), slice = lane & 15, rin = w * 4 + (lane >> 4);
    const int ts = tid >> 4, cgp = tid & 15;
    for (int unit = blockIdx.x; unit < 256; unit += gridDim.x) {
        const int chain = unit >> 1, half = unit & 1, b = chain >> 4, h = chain & 15;
        const size_t rowb = (size_t)b * SEQ;
        const f32x4 kkp = *(const f32x4*)(a.in[I_KK] + h * 64 + 4 * cgp), kap = *(const f32x4*)(a.in[I_KA] + h * 64 + 4 * cgp);
        u32x2 rr, rk, rv, re, ra;
#define SCAN_LOAD(c) do { const size_t row_ = rowb + (c) * 32 + ts; const bf16* p_ = RK + row_ * RW_N + h * 64 + 4 * cgp; \
            rr = *(const u32x2*)p_; rk = *(const u32x2*)(p_ + 1024); rv = *(const u32x2*)(p_ + 2048); \
            const bf16* q_ = EA + row_ * EA_LD + h * 64 + 4 * cgp; re = *(const u32x2*)q_; ra = *(const u32x2*)(q_ + 1024); } while (0)
#define SCAN_STORE(buf) do { float* base_ = vecs + (buf) * 6 * 2048 + ts * 64 + 4 * cgp; \
            const f32x4 r4 = (f32x4){bflo(rr.x), bfhi(rr.x), bflo(rr.y), bfhi(rr.y)}, k4 = (f32x4){bflo(rk.x), bfhi(rk.x), bflo(rk.y), bfhi(rk.y)}; \
            const f32x4 v4 = (f32x4){bflo(rv.x), bfhi(rv.x), bflo(rv.y), bfhi(rv.y)}, e4 = (f32x4){bflo(re.x), bfhi(re.x), bflo(re.y), bfhi(re.y)}; \
            const f32x4 a4 = (f32x4){bflo(ra.x), bfhi(ra.x), bflo(ra.y), bfhi(ra.y)}; \
            f32x4 w4; w4.x = __expf(-e4.x); w4.y = __expf(-e4.y); w4.z = __expf(-e4.z); w4.w = __expf(-e4.w); \
            const f32x4 kraw = k4 * kkp; float ss_ = (kraw.x * kraw.x + kraw.y * kraw.y) + (kraw.z * kraw.z + kraw.w * kraw.w); ss_ = row16_sum(ss_); \
            const float inv_ = __builtin_amdgcn_rsqf(fmaxf(ss_, 1e-24f)); const f32x4 kkn = kraw * inv_; \
            const f32x4 kt = k4 * ((a4 - 1.0f) * kap + 1.0f); const f32x4 bv = kkn * a4; \
            *(f32x4*)(base_) = r4; *(f32x4*)(base_ + 2048) = w4; *(f32x4*)(base_ + 2 * 2048) = kt; *(f32x4*)(base_ + 3 * 2048) = -kkn; \
            *(f32x4*)(base_ + 4 * 2048) = bv; *(f32x4*)(base_ + 5 * 2048) = v4; } while (0)
        SCAN_LOAD(0); SCAN_STORE(0);
        __syncthreads();
        float s0 = 0.f, s1 = 0.f, s2 = 0.f, s3 = 0.f;
        for (int c = 0; c < SEQ / 32; ++c) {
            const int buf = c & 1;
            if (c + 1 < SEQ / 32) SCAN_LOAD(c + 1);
            if (PMODE != 1) {
                const float* vb = vecs + buf * 6 * 2048 + 4 * slice;
                const float* vv = vecs + buf * 6 * 2048 + 5 * 2048 + half * 32 + rin;
                float* yb = ybuf + buf * 4096 + rin * 4 + (slice >> 2);
                f32x4 r4 = *(const f32x4*)(vb), w4 = *(const f32x4*)(vb + 2048), k4 = *(const f32x4*)(vb + 2 * 2048);
                f32x4 n4 = *(const f32x4*)(vb + 3 * 2048), b4 = *(const f32x4*)(vb + 4 * 2048);
                float v1 = *vv;
#pragma unroll 8
                for (int t = 0; t < 32; ++t) {
                    const int tn = (t + 1) & 31;
                    const f32x4 r4n = *(const f32x4*)(vb + tn * 64), w4n = *(const f32x4*)(vb + 2048 + tn * 64), k4n = *(const f32x4*)(vb + 2 * 2048 + tn * 64);
                    const f32x4 n4n = *(const f32x4*)(vb + 3 * 2048 + tn * 64), b4n = *(const f32x4*)(vb + 4 * 2048 + tn * 64);
                    const float v1n = vv[tn * 64];
                    float sa = afma(s1, n4.y, amul(s0, n4.x)) + afma(s3, n4.w, amul(s2, n4.z));
                    sa = row16_sum(sa);
                    s0 = afma(s0, w4.x, amul(b4.x, sa)); s1 = afma(s1, w4.y, amul(b4.y, sa)); s2 = afma(s2, w4.z, amul(b4.z, sa)); s3 = afma(s3, w4.w, amul(b4.w, sa));
                    s0 = afma(k4.x, v1, s0); s1 = afma(k4.y, v1, s1); s2 = afma(k4.z, v1, s2); s3 = afma(k4.w, v1, s3);
                    float y = afma(s1, r4.y, amul(s0, r4.x)) + afma(s3, r4.w, amul(s2, r4.z));
                    y += dppf<0xB1>(y); y += dppf<0x4E>(y);
                    yb[t * 128] = y;
                    r4 = r4n; w4 = w4n; k4 = k4n; n4 = n4n; b4 = b4n; v1 = v1n;
                }
            }
            if (c + 1 < SEQ / 32) SCAN_STORE(buf ^ 1);
            __syncthreads();
            {
                const f32x4 ya = *(const f32x4*)(ybuf + buf * 4096 + ts * 128 + 8 * cgp), yb4 = *(const f32x4*)(ybuf + buf * 4096 + ts * 128 + 8 * cgp + 4);
                *(unsigned*)(Y + (rowb + c * 32 + ts) * D + h * 64 + half * 32 + 2 * cgp) = pk2((ya.x + ya.y) + (ya.z + ya.w), (yb4.x + yb4.y) + (yb4.z + yb4.w));
            }
        }
        __syncthreads();
#undef SCAN_LOAD
#undef SCAN_STORE
    }
}

__device__ __forceinline__ void rwkv_post(const Args& a, int tid) {
    asm volatile("" : "+v"(tid));
    unsigned char* ws = a.ws;
    const bf16* RK = (const bf16*)(ws + WS_RK); const bf16* EA = (const bf16*)(ws + WS_A2); bf16* Y = (bf16*)(ws + WS_Y);
    const int lane = tid & 63, sub = lane & 15, grp = lane >> 4;
    const int gw = blockIdx.x * 8 + (tid >> 6), NGW = gridDim.x * 8;
    for (int row = gw; row < M; row += NGW) {
#pragma unroll
        for (int pass = 0; pass < 4; ++pass) {
            const int c = (pass * 4 + grp) * 64 + 4 * sub;
            const u32x2 yy = *(const u32x2*)(Y + (size_t)row * D + c);
            const bf16* p = RK + (size_t)row * RW_N + c;
            const u32x2 rr = *(const u32x2*)p, rk = *(const u32x2*)(p + 1024), rv = *(const u32x2*)(p + 2048);
            const u32x2 gg = *(const u32x2*)(EA + (size_t)row * EA_LD + c), aa = *(const u32x2*)(EA + (size_t)row * EA_LD + 1024 + c);
            const f32x4 y4 = (f32x4){bflo(yy.x), bfhi(yy.x), bflo(yy.y), bfhi(yy.y)};
            const f32x4 r4 = (f32x4){bflo(rr.x), bfhi(rr.x), bflo(rr.y), bfhi(rr.y)}, k4 = (f32x4){bflo(rk.x), bfhi(rk.x), bflo(rk.y), bfhi(rk.y)};
            const f32x4 v4 = (f32x4){bflo(rv.x), bfhi(rv.x), bflo(rv.y), bfhi(rv.y)}, g4 = (f32x4){bflo(gg.x), bfhi(gg.x), bflo(gg.y), bfhi(gg.y)};
            const f32x4 a4 = (f32x4){bflo(aa.x), bfhi(aa.x), bflo(aa.y), bfhi(aa.y)};
            const f32x4 kap = *(const f32x4*)(a.in[I_KA] + c), rkp = *(const f32x4*)(a.in[I_RK] + c), lw = *(const f32x4*)(a.in[I_LNW] + c), lb = *(const f32x4*)(a.in[I_LNB] + c);
            const float mean = row16_sum((y4.x + y4.y) + (y4.z + y4.w)) * (1.f / 64.f);
            const f32x4 d4 = y4 - mean;
            const float var = row16_sum((d4.x * d4.x + d4.y * d4.y) + (d4.z * d4.z + d4.w * d4.w)) * (1.f / 64.f);
            const float rstd = __builtin_amdgcn_rsqf(var + 64e-5f);
            const f32x4 kt = k4 * ((a4 - 1.0f) * kap + 1.0f);
            const f32x4 rkk = r4 * kt * rkp;
            const float sd = row16_sum((rkk.x + rkk.y) + (rkk.z + rkk.w));
            const f32x4 o = ((d4 * rstd) * lw + lb + v4 * sd) * g4;
            u32x2 ov; ov.x = pk2(o.x, o.y); ov.y = pk2(o.z, o.w);
            *(u32x2*)(Y + (size_t)row * D + c) = ov;
        }
    }
}

__device__ __forceinline__ void rwkv_mixer(const Args& a, unsigned char* lds, const XcdBarrier& bar, const float* modl, int tid) {
    unsigned char* ws = a.ws;
    bf16* A2 = (bf16*)(ws + WS_A2); bf16* RK = (bf16*)(ws + WS_RK); bf16* Y = (bf16*)(ws + WS_Y);
    const bf16* WL = (const bf16*)(ws + WS_WLORA);
    norm_phase(a.out, modl, 1, A2, 1, tid);
    xcd_barrier(bar);
    for (int rep = 0; rep < REP_RWIN; ++rep) { pg8::EpiBf16<1> E{RK, RW_N, nullptr, nullptr}; run_gemm(lds, A2, RW_K, (const bf16*)(ws + WS_WRWIN), M, RW_N, RW_K, E); xcd_barrier(bar); }
    { pg8::EpiBf16<2> E{A2, EA_LD, a.in[I_W0], a.in[I_A0]}; run_gemm(lds, RK + 3072, RW_N, WL, M, 2048, LORA_K, E); }
    xcd_barrier(bar);
    #if defined(PROBE_SCAN_STAGE)
    rwkv_scan<1>(a, lds, tid); xcd_barrier(bar);
#endif
    for (int rep = 0; rep < REP_SCAN; ++rep) { rwkv_scan<0>(a, lds, tid); xcd_barrier(bar); }
    { pg8::EpiBf16<0> E{A2, EA_LD, nullptr, nullptr}; run_gemm(lds, RK + 3072, RW_N, WL + (size_t)2048 * LORA_K, M, 1024, LORA_K, E); }
    xcd_barrier(bar);
    rwkv_post(a, tid);
    xcd_barrier(bar);
    { pg8::EpiResid<true, false> E{a.out, a.out, modl + 5 * D, (bf16*)(ws + WS_U), modl + 7 * D, (float*)(ws + WS_PART)}; run_gemm(lds, Y, D, (const bf16*)(ws + WS_WRWOUT), M, D, D, E); }
    xcd_barrier(bar);
}

#ifndef REP_P0
#define REP_P0 1
#endif
#ifndef REP_NORM
#define REP_NORM 1
#endif
#ifndef REP_DOWN
#define REP_DOWN 1
#endif
#ifndef REP_GU
#define REP_GU 1
#endif
#ifndef ENABLE_DSA
#define ENABLE_DSA 1
#endif
#ifndef ENABLE_RWKV
#define ENABLE_RWKV 1
#endif
template <int L> __device__ __forceinline__ void layer_body(const Args& a, unsigned char* lds, const XcdBarrier& bar, int tid) {
    unsigned char* ws = a.ws;
    const float* MOD = (const float*)(ws + WS_MOD);
    bf16* U = (bf16*)(ws + WS_U);
    bf16* ACT = (bf16*)(ws + WS_ACT);
    float* H = a.out;
    float* PART = (float*)(ws + WS_PART); const float* BV = (const float*)(ws + WS_BIAS);
#define GSYNC() xcd_barrier(bar)

        const float* modl = MOD + (size_t)L * 8 * NMOD;
        const bf16* wgu0 = (const bf16*)(ws + (L == 0 ? WS_WGU0 : WS_WGU1));
        const bf16* wdn0 = (const bf16*)(ws + (L == 0 ? WS_WDN0 : WS_WDN1));
        if (L == 0) { for (int rep = 0; rep < REP_GU; ++rep) { pg8::EpiSwiglu<false> E{ACT, DFF, nullptr, nullptr}; run_gemm(lds, U, D, wgu0, M, 2 * DFF, D, E); GSYNC(); } }
        else { pg8::EpiSwiglu<true> E{ACT, DFF, PART, BV + BV_GU1A}; run_gemm(lds, U, D, wgu0, M, 2 * DFF, D, E); GSYNC(); }
        if (L == 0) {
            for (int rep = 0; rep < REP_DOWN; ++rep) { pg8::EpiResid<true, true> E{a.in[I_X], H, modl + 2 * D, U, modl + 4 * D, PART}; run_gemm(lds, ACT, DFF, wdn0, M, D, DFF, E); GSYNC(); }
            dsa_mixer(a, lds, bar, modl, tid);
        } else {
            { pg8::EpiResid<false, true> E{H, H, modl + 2 * D, nullptr, nullptr, nullptr}; run_gemm(lds, ACT, DFF, wdn0, M, D, DFF, E); }
            GSYNC();
            rwkv_mixer(a, lds, bar, modl, tid);
        }
        { pg8::EpiSwiglu<true> E{ACT, DFF, PART, BV + (L == 0 ? BV_GU0B : BV_GU1B)}; run_gemm(lds, U, D, wgu0 + (size_t)2 * DFF * D, M, 2 * DFF, D, E); }
        GSYNC();
        if (L == 0) { pg8::EpiResid<true, true> E{H, H, modl + 8 * D, U, MOD + (size_t)8 * NMOD + D, PART}; run_gemm(lds, ACT, DFF, wdn0 + (size_t)D * DFF, M, D, DFF, E); }
        else { pg8::EpiResid<false, true> E{H, H, modl + 8 * D, nullptr, nullptr, nullptr}; run_gemm(lds, ACT, DFF, wdn0 + (size_t)D * DFF, M, D, DFF, E); }
        GSYNC();

#undef GSYNC
}
__global__ void __launch_bounds__(NTHREADS, 2) mega_fwd(Args a) {
    extern __shared__ __attribute__((aligned(16))) unsigned char lds[];
    cg::grid_group grid = cg::this_grid();
    const int tid = threadIdx.x;
    unsigned char* ws = a.ws;
    const float* MOD = (const float*)(ws + WS_MOD);
    bf16* U = (bf16*)(ws + WS_U);
    bf16* ACT = (bf16*)(ws + WS_ACT);
    float* H = a.out;

    if (tid < 2) ((volatile LAS unsigned*)((LAS unsigned char*)lds + XB_LDS_OFF))[tid] = 0u;
    __syncthreads();
    for (int rep = 0; rep < REP_P0; ++rep) { p0_prep(a, lds, tid); grid.sync(); }
    const XcdBarrier bar = xcd_barrier_post((unsigned*)(ws + WS_BAR), (volatile LAS unsigned*)((LAS unsigned char*)lds + XB_LDS_OFF));
#define GSYNC() xcd_barrier(bar)

    float* PART = (float*)(ws + WS_PART); const float* BV = (const float*)(ws + WS_BIAS);
    for (int rep = 0; rep < REP_NORM; ++rep) { norm_phase(a.in[I_X], MOD, 0, U, 0, tid); bias_phase(ws, tid); GSYNC(); }
    layer_body<0>(a, lds, bar, tid);
    layer_body<1>(a, lds, bar, tid);
}

extern "C" void kernel_launch(void* const* d_in, const int* in_sizes, int n_in, void* d_out, int out_size, void* d_ws, size_t ws_size, hipStream_t stream) {
    static int grid = 0;
    if (grid == 0) {
        if (n_in != 27 || out_size != M * D || ws_size < WS_NEED) { fprintf(stderr, "kernel_launch: unexpected shapes (n_in %d out %d ws %zu)\n", n_in, out_size, ws_size); grid = -1; return; }
        int dev = 0, cus = 0, per_cu = 0;
        hipGetDevice(&dev);
        hipDeviceGetAttribute(&cus, hipDeviceAttributeMultiprocessorCount, dev);
        hipFuncSetAttribute((const void*)mega_fwd, hipFuncAttributeMaxDynamicSharedMemorySize, LDS_BYTES);
        hipOccupancyMaxActiveBlocksPerMultiprocessor(&per_cu, (const void*)mega_fwd, NTHREADS, LDS_BYTES);
        if (per_cu < 1) per_cu = 1;
        grid = cus * per_cu;
        (void)hipGetLastError();
    }
    if (grid < 0) return;
    Args a{};
    for (int i = 0; i < 27; ++i) a.in[i] = (const float*)d_in[i];
    a.out = (float*)d_out; a.ws = (unsigned char*)d_ws;
    void* args[] = {&a};
    hipError_t e = hipLaunchCooperativeKernel((void*)mega_fwd, dim3(grid), dim3(NTHREADS), args, LDS_BYTES, stream);
    if (e != hipSuccess) fprintf(stderr, "cooperative launch failed: %s (grid %d)\n", hipGetErrorString(e), grid);
}
```
